# Optimizing an MI355X kernel written in HIP

```python
import math
import jax, jax.numpy as jnp
from jax import lax
import numpy as np

D_MODEL = 1024
BATCH = 16
SEQ = 2048
DEPTH = 4

CHUNK = 64
Q_BLOCK = 128
N_MEM = 256
N_A_LAYERS = DEPTH // 2
N_B_LAYERS = DEPTH - N_A_LAYERS
EPS = 1e-6
M_HEADS = 4
M_HEAD_DIM = D_MODEL // M_HEADS
M_WIDTH = M_HEADS * M_HEAD_DIM
CONV_W = 4
B_HEADS = 8
QK_NOPE = 128
QK_ROPE = 64
QK_HEAD = QK_NOPE + QK_ROPE
V_HEAD = 128
B_WIDTH = B_HEADS * V_HEAD
Q_LORA = 384
KV_LORA = 256
ROPE_THETA = 10000.0
MEM_HEADS = 4
MEM_HEAD_DIM = 128
MEM_WIDTH = MEM_HEADS * MEM_HEAD_DIM
A_IN = 2 * M_WIDTH + 3 * M_WIDTH + 2 * M_HEADS + 2 * MEM_WIDTH
B_IN = Q_LORA + B_WIDTH + 2 * MEM_WIDTH
A_MIX = M_WIDTH + MEM_WIDTH
B_MIX = B_WIDTH + MEM_WIDTH

kernel_name = "yoco_mlstm_mla_memory_trunk"


def rmsnorm(t, g):
    tf = t.astype(jnp.float32)
    y = tf * lax.rsqrt(jnp.mean(tf * tf, axis=-1, keepdims=True) + EPS)
    return (y * g.astype(jnp.float32)).astype(t.dtype)


def split_cols(t, sizes):
    offs = np.cumsum(np.array(sizes))[:-1].tolist()
    return jnp.split(t, offs, axis=-1)


def rope(t, positions):
    half = QK_ROPE // 2
    inv = ROPE_THETA ** (-jnp.arange(0, QK_ROPE, 2, dtype=jnp.float32) / QK_ROPE)
    ang = positions.astype(jnp.float32)[..., None] * inv
    cos = jnp.cos(ang)[:, :, None, :]
    sin = jnp.sin(ang)[:, :, None, :]
    tf = t.astype(jnp.float32)
    t1, t2 = tf[..., :half], tf[..., half:]
    return jnp.concatenate([t1 * cos - t2 * sin, t1 * sin + t2 * cos], axis=-1).astype(t.dtype)


def causal_conv(u, w, b):
    out = lax.conv_general_dilated(
        u, w[:, None, :].astype(u.dtype), window_strides=(1,), padding=[(CONV_W - 1, 0)],
        dimension_numbers=("NWC", "WIO", "NWC"), feature_group_count=u.shape[-1])
    return out + b.astype(u.dtype)


def mlstm_chunkwise(q, k, v, i_pre, f_pre):
    bsz, s, h, dh = q.shape
    nc = s // CHUNK

    def to_chunks(t):
        return t.astype(jnp.float32).reshape(bsz, nc, CHUNK, h, -1).transpose(1, 0, 3, 2, 4)

    def gate_chunks(t):
        return t.astype(jnp.float32).reshape(bsz, nc, CHUNK, h).transpose(1, 0, 3, 2)

    qc = to_chunks(q) * (dh ** -0.5)
    kc = to_chunks(k)
    vc = to_chunks(v)
    ic = gate_chunks(i_pre)
    lfc = jax.nn.log_sigmoid(gate_chunks(f_pre))
    causal = jnp.tril(jnp.ones((CHUNK, CHUNK), dtype=bool))

    def step(carry, inp):
        c_mat, n_vec, m = carry
        qb, kb, vb, ib, fb = inp
        b = jnp.cumsum(fb, axis=-1)
        d = b[..., :, None] - b[..., None, :] + ib[..., None, :]
        d = jnp.where(causal, d, -jnp.inf)
        inter = b + m[..., None]
        m_t = jnp.maximum(inter, jnp.max(d, axis=-1))
        p = jnp.einsum("bhtd,bhsd->bhts", qb, kb) * jnp.exp(d - m_t[..., None])
        g = jnp.exp(inter - m_t)
        num = jnp.einsum("bhts,bhsv->bhtv", p, vb) + g[..., None] * jnp.einsum("bhvk,bhtk->bhtv", c_mat, qb)
        den = jnp.sum(p, axis=-1) + g * jnp.einsum("bhk,bhtk->bht", n_vec, qb)
        h_out = num / jnp.maximum(jnp.abs(den), jnp.exp(-m_t))[..., None]
        b_last = b[..., -1]
        a = b_last[..., None] - b + ib
        m_new = jnp.maximum(b_last + m, jnp.max(a, axis=-1))
        wa = jnp.exp(a - m_new[..., None])
        gs = jnp.exp(b_last + m - m_new)
        c_new = gs[..., None, None] * c_mat + jnp.einsum("bhs,bhsv,bhsk->bhvk", wa, vb, kb)
        n_new = gs[..., None] * n_vec + jnp.einsum("bhs,bhsk->bhk", wa, kb)
        return (c_new, n_new, m_new), h_out

    init = (jnp.zeros((bsz, h, dh, dh), jnp.float32), jnp.zeros((bsz, h, dh), jnp.float32),
            jnp.zeros((bsz, h), jnp.float32))
    _, hs = lax.scan(step, init, (qc, kc, vc, ic, lfc))
    return hs.transpose(1, 0, 3, 2, 4).reshape(bsz, s, h, dh)


def chunk_causal_attention(q, k, v):
    s = q.shape[1]
    scale = QK_HEAD ** -0.5
    outs = []
    for j in range(s // Q_BLOCK):
        qs = j * Q_BLOCK
        ke = qs + Q_BLOCK
        sc = jnp.einsum("bqhd,bkhd->bhqk", q[:, qs:ke], k[:, :ke],
                        preferred_element_type=jnp.float32) * scale
        q_chunk = (qs + jnp.arange(Q_BLOCK)) // CHUNK
        k_chunk = jnp.arange(ke) // CHUNK
        sc = jnp.where(k_chunk[None, :] <= q_chunk[:, None], sc, -jnp.inf)
        p = jax.nn.softmax(sc, axis=-1).astype(v.dtype)
        outs.append(jnp.einsum("bhqk,bkhd->bqhd", p, v[:, :ke]))
    return jnp.concatenate(outs, axis=1)


def memory_kv(mem_n, w_kv, k_gain):
    bsz, nm, _ = mem_n.shape
    mk, mv = split_cols(mem_n @ w_kv, [MEM_WIDTH, MEM_WIDTH])
    mk = rmsnorm(mk.reshape(bsz, nm, MEM_HEADS, MEM_HEAD_DIM), k_gain)
    return mk, mv.reshape(bsz, nm, MEM_HEADS, MEM_HEAD_DIM)


def memory_attention(mq, mz, mk, mv, q_gain):
    bsz, s, _ = mq.shape
    q = rmsnorm(mq.reshape(bsz, s, MEM_HEADS, MEM_HEAD_DIM), q_gain)
    sc = jnp.einsum("bqhd,bkhd->bhqk", q, mk, preferred_element_type=jnp.float32) * (MEM_HEAD_DIM ** -0.5)
    p = jax.nn.softmax(sc, axis=-1).astype(mv.dtype)
    out = jnp.einsum("bhqk,bkhd->bqhd", p, mv).reshape(bsz, s, MEM_WIDTH)
    return out * jax.nn.silu(mz)


def mlstm_layer(x, norm_g, w_in, conv_w, conv_b, ig_b, fg_b, h_g, w_out, mk, mv, mq_gain):
    bsz, s, _ = x.shape
    h = rmsnorm(x, norm_g)
    qk, v, o, z, i_pre, f_pre, mq, mz = split_cols(
        h @ w_in, [2 * M_WIDTH, M_WIDTH, M_WIDTH, M_WIDTH, M_HEADS, M_HEADS, MEM_WIDTH, MEM_WIDTH])
    qk = jax.nn.silu(causal_conv(qk, conv_w, conv_b))
    q, k = split_cols(qk, [M_WIDTH, M_WIDTH])
    heads = (bsz, s, M_HEADS, M_HEAD_DIM)
    ht = mlstm_chunkwise(q.reshape(heads), k.reshape(heads), v.reshape(heads),
                         i_pre + ig_b, f_pre + fg_b).astype(x.dtype)
    ht = rmsnorm(ht, h_g.reshape(M_HEADS, M_HEAD_DIM)).reshape(bsz, s, M_WIDTH)
    y_m = jax.nn.sigmoid(o) * ht * jax.nn.silu(z)
    y_mem = memory_attention(mq, mz, mk, mv, mq_gain)
    return x + jnp.concatenate([y_m, y_mem], axis=-1) @ w_out


def shared_kv(x, positions, kv_norm, w_kv_a, kv_lat_norm, w_kv_b, k_gain):
    bsz, s, _ = x.shape
    h = rmsnorm(x, kv_norm)
    c_kv, k_pe = split_cols(h @ w_kv_a, [KV_LORA, QK_ROPE])
    kv = (rmsnorm(c_kv, kv_lat_norm) @ w_kv_b).reshape(bsz, s, B_HEADS, QK_NOPE + V_HEAD)
    k_nope, v = kv[..., :QK_NOPE], kv[..., QK_NOPE:]
    k = jnp.concatenate([k_nope, jnp.broadcast_to(k_pe[:, :, None, :], (bsz, s, B_HEADS, QK_ROPE))], axis=-1)
    k = rmsnorm(k, k_gain)
    k = jnp.concatenate([k[..., :QK_NOPE], rope(k[..., QK_NOPE:], positions)], axis=-1)
    return k, v


def mla_layer(x, positions, k_sh, v_sh, norm_g, w_in, q_lat_g, w_q_up, q_gain, w_out, mk, mv, mq_gain):
    bsz, s, _ = x.shape
    h = rmsnorm(x, norm_g)
    q_lat, z, mq, mz = split_cols(h @ w_in, [Q_LORA, B_WIDTH, MEM_WIDTH, MEM_WIDTH])
    q = (rmsnorm(q_lat, q_lat_g) @ w_q_up).reshape(bsz, s, B_HEADS, QK_HEAD)
    q = rmsnorm(q, q_gain)
    q = jnp.concatenate([q[..., :QK_NOPE], rope(q[..., QK_NOPE:], positions)], axis=-1)
    attn = chunk_causal_attention(q, k_sh, v_sh).reshape(bsz, s, B_WIDTH)
    y_b = attn * jax.nn.silu(z)
    y_mem = memory_attention(mq, mz, mk, mv, mq_gain)
    return x + jnp.concatenate([y_b, y_mem], axis=-1) @ w_out


def setup_inputs(seed: int = 0) -> dict:
    key = jax.random.key(seed)
    ks = jax.random.split(key, 32)

    def nrm(k, shape, scale):
        return jax.random.normal(k, shape, jnp.float32) * scale

    def gain(k, shape):
        return 1.0 + 0.02 * jax.random.normal(k, shape, jnp.float32)

    offsets = jax.random.randint(ks[2], (BATCH,), 0, 4096, dtype=jnp.int32)
    positions = (offsets[:, None] + jnp.arange(SEQ, dtype=jnp.int32)[None, :]).astype(jnp.int32)
    fg_base = jnp.linspace(3.0, 6.0, M_HEADS, dtype=jnp.float32)
    return {
        "x": nrm(ks[0], (BATCH, SEQ, D_MODEL), 1.0),
        "mem": nrm(ks[1], (BATCH, N_MEM, D_MODEL), 1.0),
        "positions": positions,
        "a_norm": gain(ks[3], (N_A_LAYERS, D_MODEL)),
        "a_w_in": nrm(ks[4], (N_A_LAYERS, D_MODEL, A_IN), D_MODEL ** -0.5),
        "a_conv_w": nrm(ks[5], (N_A_LAYERS, CONV_W, 2 * M_WIDTH), CONV_W ** -0.5),
        "a_conv_b": nrm(ks[6], (N_A_LAYERS, 2 * M_WIDTH), 0.01),
        "a_ig_bias": nrm(ks[7], (N_A_LAYERS, M_HEADS), 0.1),
        "a_fg_bias": fg_base[None, :] + nrm(ks[8], (N_A_LAYERS, M_HEADS), 0.1),
        "a_h_norm": gain(ks[9], (N_A_LAYERS, M_WIDTH)),
        "a_w_out": nrm(ks[10], (N_A_LAYERS, A_MIX, D_MODEL), A_MIX ** -0.5),
        "b_norm": gain(ks[11], (N_B_LAYERS, D_MODEL)),
        "b_w_in": nrm(ks[12], (N_B_LAYERS, D_MODEL, B_IN), D_MODEL ** -0.5),
        "b_q_lat_norm": gain(ks[13], (N_B_LAYERS, Q_LORA)),
        "b_w_q_up": nrm(ks[14], (N_B_LAYERS, Q_LORA, B_HEADS * QK_HEAD), Q_LORA ** -0.5),
        "b_q_gain": gain(ks[15], (N_B_LAYERS, QK_HEAD)),
        "b_w_out": nrm(ks[16], (N_B_LAYERS, B_MIX, D_MODEL), B_MIX ** -0.5),
        "kv_norm": gain(ks[17], (D_MODEL,)),
        "w_kv_a": nrm(ks[18], (D_MODEL, KV_LORA + QK_ROPE), D_MODEL ** -0.5),
        "kv_lat_norm": gain(ks[19], (KV_LORA,)),
        "w_kv_b": nrm(ks[20], (KV_LORA, B_HEADS * (QK_NOPE + V_HEAD)), KV_LORA ** -0.5),
        "k_gain": gain(ks[21], (QK_HEAD,)),
        "mem_norm": gain(ks[22], (D_MODEL,)),
        "mem_w_kv": nrm(ks[23], (DEPTH, D_MODEL, 2 * MEM_WIDTH), D_MODEL ** -0.5),
        "mem_q_gain": gain(ks[24], (DEPTH, MEM_HEAD_DIM)),
        "mem_k_gain": gain(ks[25], (DEPTH, MEM_HEAD_DIM)),
    }


def reference(x, mem, positions, a_norm, a_w_in, a_conv_w, a_conv_b, a_ig_bias, a_fg_bias, a_h_norm, a_w_out,
              b_norm, b_w_in, b_q_lat_norm, b_w_q_up, b_q_gain, b_w_out,
              kv_norm, w_kv_a, kv_lat_norm, w_kv_b, k_gain,
              mem_norm, mem_w_kv, mem_q_gain, mem_k_gain):
    mem_n = rmsnorm(mem, mem_norm)
    k_sh = None
    v_sh = None
    for layer in range(DEPTH):
        mk, mv = memory_kv(mem_n, mem_w_kv[layer], mem_k_gain[layer])
        if layer < N_A_LAYERS:
            x = mlstm_layer(x, a_norm[layer], a_w_in[layer], a_conv_w[layer], a_conv_b[layer],
                            a_ig_bias[layer], a_fg_bias[layer], a_h_norm[layer], a_w_out[layer],
                            mk, mv, mem_q_gain[layer])
        else:
            if layer == N_A_LAYERS:
                k_sh, v_sh = shared_kv(x, positions, kv_norm, w_kv_a, kv_lat_norm, w_kv_b, k_gain)
            j = layer - N_A_LAYERS
            x = mla_layer(x, positions, k_sh, v_sh, b_norm[j], b_w_in[j], b_q_lat_norm[j], b_w_q_up[j],
                          b_q_gain[j], b_w_out[j], mk, mv, mem_q_gain[layer])
    return x
```

```cpp
#include <hip/hip_runtime.h>
#include <cstdio>
#include <cstdint>

namespace pg8 {
#define PG8_LAS __attribute__((address_space(3)))
typedef unsigned short bf16_t;
typedef short bf16x8 __attribute__((ext_vector_type(8)));
typedef float f32x4 __attribute__((ext_vector_type(4)));
typedef unsigned u32x4 __attribute__((ext_vector_type(4)));
typedef unsigned u32x2 __attribute__((ext_vector_type(2)));
constexpr int BM = 256, BK = 64, HALF = 128, HTB = HALF * BK * 2  , STAGE_BYTES = 8 * HTB, NXCD = 8, WGM = 8;

__host__ __device__ __forceinline__ int lds_byte(int r, int c) { const int st = (r >> 4) * 2 + (c >> 5), rr = r & 15, cc = c & 31, ob = rr * 64 + cc * 2; return st * 1024 + (ob ^ (((ob >> 9) & 1) << 5)); }
__host__ __device__ __forceinline__ void stage_rc(int b, int& R, int& C) { const int st = b / 1024, sb = b % 1024, swz = sb ^ (((sb >> 9) & 1) << 5); R = (st >> 1) * 16 + swz / 64; C = (st & 1) * 32 + (swz % 64) / 2; }
__host__ __device__ __forceinline__ int perm32(int rho) { const int n = rho >> 4, i = rho & 15; return 8 * (i >> 2) + 4 * n + (i & 3); }

struct Unit { int pm, pn; };
struct Gemm { const bf16_t* A; const bf16_t* A2; const bf16_t* Bt; int M, N, K, lda, ks; };

struct StaticOrder {
    int nM, nN, nwg, G, c;
    __host__ __device__ void init(int M, int N, int G_, int c_) { nM = M / BM; nN = N / BM; nwg = nM * nN; G = G_; c = c_; }
    __host__ __device__ bool next(int i, Unit& u) const {
        const long L = (long)i * G + c; if (L >= nwg) return false;
        int wgid = (int)L; { const int q = nwg / NXCD, r = nwg % NXCD, xcd = wgid % NXCD, off = wgid / NXCD; wgid = (xcd < r ? xcd * (q + 1) : r * (q + 1) + (xcd - r) * q) + off; }
        const int nig = WGM * nN, gid = wgid / nig, fm = gid * WGM, gsz = (nM - fm) < WGM ? (nM - fm) : WGM;
        u.pm = fm + ((wgid % nig) % gsz); u.pn = (wgid % nig) / gsz; return true;
    }
    __device__ __forceinline__ void a_ready(const Unit&) const {}
    __device__ __forceinline__ void done(const Unit&) const {}
};
__device__ __forceinline__ unsigned cvt_pk_bf16(float lo, float hi) { unsigned r; asm volatile("v_cvt_pk_bf16_f32 %0, %1, %2" : "=v"(r) : "v"(lo), "v"(hi)); return r; }
template <class Epi, class Sched, bool ALIGN_EPI = false, bool SP2 = false>
__device__ __forceinline__ void gemm_phase(PG8_LAS unsigned char* lds, const Gemm g, const Sched& S, const Epi& E, const int tid) {
    const int wid = __builtin_amdgcn_readfirstlane(tid >> 6), lane = tid & 63, wr = wid >> 2, wc = wid & 3, fr = lane & 15, fq = lane >> 4;
    const int K = g.K, nt = K / BK;
    unsigned voffA[2], voffB[2], voffB1[2];
#pragma unroll
    for (int i = 0; i < 2; ++i) { int R, C; stage_rc(tid * 16 + i * 8192, R, C); const int Rb = Epi::PERM ? ((R & ~31) + perm32(R & 31)) : R;
        voffA[i] = (unsigned)(R * g.lda + C) * 2u;
        if (Epi::PERM) { const int gr = 64 * (R >> 5) + perm32(R & 31); voffB[i] = (unsigned)(gr * K + C) * 2u; voffB1[i] = (unsigned)((gr + 32) * K + C) * 2u; }
        else { voffB[i] = (unsigned)(Rb * K + C) * 2u; voffB1[i] = voffB[i]; } }

    const size_t kstep = (size_t)(BK * 2);
    const size_t hstep = (size_t)HALF * K * 2;
    const size_t tstep = 2 * hstep;
    const size_t hB1 = Epi::PERM ? (size_t)0 : hstep;
    const size_t hstepA = (size_t)HALF * g.lda * 2, tstepA = 2 * hstepA;
    const int ks = g.ks;
#define PG8_AP(uoff, tt) (((tt) < ks) ? ((const char*)g.A + (uoff) + (size_t)(tt) * kstep) : ((const char*)g.A2 + (uoff) + (size_t)((tt) - ks) * kstep))
    const unsigned ldsw = (unsigned)wid * 1024u;
    const int aoff = lds_byte(wr * 64 + fr, fq * 8), boff = lds_byte(wc * 32 + fr, fq * 8);
#define PG8_SA(b, h) (((b) * 2 + (h)) * HTB)
#define PG8_SB(b, h) ((4 + (b) * 2 + (h)) * HTB)
#define PG8_STAGE(bufoff, gbase, voff) do { _Pragma("unroll") for (int _i = 0; _i < 2; ++_i) \
        __builtin_amdgcn_global_load_lds((const unsigned*)((const char*)(gbase) + (voff)[_i]), (PG8_LAS unsigned*)(lds + (bufoff) + ldsw + _i * 8192), 16, 0, 0); } while (0)
#define PG8_LDA(dst, b, h) do { _Pragma("unroll") for (int m = 0; m < 4; ++m) _Pragma("unroll") for (int k = 0; k < 2; ++k) dst[m][k] = *(const PG8_LAS bf16x8*)(lds + PG8_SA(b, h) + aoff + m * 2048 + k * 1024); } while (0)
#define PG8_LDB(dst, b, h) do { _Pragma("unroll") for (int n = 0; n < 2; ++n) _Pragma("unroll") for (int k = 0; k < 2; ++k) dst[n][k] = *(const PG8_LAS bf16x8*)(lds + PG8_SB(b, h) + boff + n * 2048 + k * 1024); } while (0)
#define PG8_MMA(ai, bj, At, Bt) do { __builtin_amdgcn_s_setprio(1); _Pragma("unroll") for (int m = 0; m < 4; ++m) _Pragma("unroll") for (int n = 0; n < 2; ++n) _Pragma("unroll") for (int k = 0; k < 2; ++k) \
        acc[ai][bj][m][n] = __builtin_amdgcn_mfma_f32_16x16x32_bf16(Bt[n][k], At[m][k], acc[ai][bj][m][n], 0, 0, 0); __builtin_amdgcn_s_setprio(0); } while (0)
#define PG8_WAIT_V(n) asm volatile("s_waitcnt vmcnt(" #n ")" ::: "memory")
#define PG8_WAIT_L(n) asm volatile("s_waitcnt lgkmcnt(" #n ")" ::: "memory")
#define PG8_BAR __builtin_amdgcn_s_barrier()
#define PG8_SCHED __builtin_amdgcn_sched_barrier(0)
    Unit cur, nxt; int ui = 0;
    if (!S.next(0, cur)) return;
    f32x4 acc[2][2][4][2];
#pragma unroll
    for (int a = 0; a < 2; ++a)
#pragma unroll
        for (int b = 0; b < 2; ++b)
#pragma unroll
            for (int m = 0; m < 4; ++m)
#pragma unroll
                for (int n = 0; n < 2; ++n) acc[a][b][m][n] = (f32x4){0.f, 0.f, 0.f, 0.f};
    bf16x8 At[4][2], B0[2][2], B1[2][2];
    size_t uA = (size_t)cur.pm * tstepA; const char* cB = (const char*)g.Bt + (size_t)cur.pn * tstep;
    S.a_ready(cur);
    if constexpr (SP2) {
        PG8_STAGE(PG8_SB(0, 0), cB, voffB); PG8_STAGE(PG8_SB(0, 1), cB + hB1, voffB1); PG8_STAGE(PG8_SA(0, 0), PG8_AP(uA, 0), voffA); PG8_STAGE(PG8_SA(0, 1), PG8_AP(uA, 0) + hstepA, voffA);
        if (wr == 1) PG8_BAR;
        PG8_WAIT_V(2); PG8_BAR;
        PG8_STAGE(PG8_SB(1, 0), cB + kstep, voffB); PG8_STAGE(PG8_SA(1, 0), PG8_AP(uA, 1), voffA); PG8_STAGE(PG8_SB(1, 1), cB + hB1 + kstep, voffB1);
        PG8_WAIT_V(6); PG8_BAR;
    } else {
        PG8_STAGE(PG8_SB(0, 0), cB, voffB); PG8_STAGE(PG8_SA(0, 0), PG8_AP(uA, 0), voffA); PG8_STAGE(PG8_SB(0, 1), cB + hB1, voffB1); PG8_STAGE(PG8_SA(0, 1), PG8_AP(uA, 0) + hstepA, voffA);
        if (wr == 1) PG8_BAR;
        PG8_WAIT_V(4); PG8_BAR;
        PG8_STAGE(PG8_SB(1, 0), cB + kstep, voffB); PG8_STAGE(PG8_SA(1, 0), PG8_AP(uA, 1), voffA); PG8_STAGE(PG8_SB(1, 1), cB + hB1 + kstep, voffB1);
        PG8_WAIT_V(6); PG8_BAR;
    }
    for (;;) {
        const bool has_next = S.next(ui + 1, nxt);
        const size_t nuA = has_next ? (size_t)nxt.pm * tstepA : uA; const char* nB = has_next ? (const char*)g.Bt + (size_t)nxt.pn * tstep : cB;
        for (int t = 0; t < nt; t += 2) {
            const bool last = (t == nt - 2);
            const char* a1 = PG8_AP(uA, t + 1);
            const char* a2 = last ? PG8_AP(nuA, 0) : PG8_AP(uA, t + 2); const char* b2 = last ? nB : cB + (size_t)(t + 2) * kstep;
            const char* a3 = last ? PG8_AP(nuA, 1) : PG8_AP(uA, t + 3); const char* b3 = b2 + kstep;
            if (last && has_next) S.a_ready(nxt);
            if constexpr (SP2) {
            PG8_LDB(B0, 0, 0); PG8_LDB(B1, 0, 1); PG8_SCHED; PG8_LDA(At, 0, 0); PG8_STAGE(PG8_SA(1, 1), a1 + hstepA, voffA);
            PG8_WAIT_V(8); PG8_WAIT_L(0); PG8_BAR; PG8_MMA(0, 0, At, B0); PG8_MMA(0, 1, At, B1); PG8_BAR; PG8_SCHED;
            PG8_LDA(At, 0, 1); PG8_STAGE(PG8_SB(0, 0), b2, voffB); PG8_STAGE(PG8_SB(0, 1), b2 + hB1, voffB1); PG8_STAGE(PG8_SA(0, 0), a2, voffA);
            PG8_WAIT_V(8); PG8_WAIT_L(0); PG8_BAR; PG8_MMA(1, 0, At, B0); PG8_MMA(1, 1, At, B1); PG8_BAR; PG8_SCHED;
            PG8_LDB(B0, 1, 0); PG8_LDB(B1, 1, 1); PG8_SCHED; PG8_LDA(At, 1, 0); PG8_STAGE(PG8_SA(0, 1), a2 + hstepA, voffA);
            PG8_WAIT_V(8); PG8_WAIT_L(0); PG8_BAR; PG8_MMA(0, 0, At, B0); PG8_MMA(0, 1, At, B1); PG8_BAR; PG8_SCHED;
            PG8_LDA(At, 1, 1); PG8_STAGE(PG8_SB(1, 0), b3, voffB); PG8_STAGE(PG8_SB(1, 1), b3 + hB1, voffB1); PG8_STAGE(PG8_SA(1, 0), a3, voffA);
            PG8_WAIT_V(8); PG8_WAIT_L(0); PG8_BAR; PG8_MMA(1, 0, At, B0); PG8_MMA(1, 1, At, B1); PG8_BAR; PG8_SCHED;
            if constexpr (Epi::KSCALE) { if ((t & 3) == 2 && t < 16) E.kscale(acc, ui, t >> 2, wr, fr); }
            } else {
            PG8_LDB(B0, 0, 0); PG8_SCHED; PG8_LDA(At, 0, 0); PG8_STAGE(PG8_SA(1, 1), a1 + hstepA, voffA);
            PG8_WAIT_L(8); PG8_BAR; PG8_WAIT_L(0); PG8_MMA(0, 0, At, B0); PG8_BAR; PG8_SCHED;
            PG8_LDB(B1, 0, 1); PG8_STAGE(PG8_SB(0, 0), b2, voffB);
            PG8_BAR; PG8_WAIT_L(0); PG8_MMA(0, 1, At, B1); PG8_BAR;
            PG8_LDA(At, 0, 1); PG8_STAGE(PG8_SA(0, 0), a2, voffA);
            PG8_BAR; PG8_WAIT_L(0); PG8_MMA(1, 0, At, B0); PG8_BAR; PG8_SCHED;
            PG8_STAGE(PG8_SB(0, 1), b2 + hB1, voffB1);
            PG8_WAIT_V(6); PG8_BAR; PG8_MMA(1, 1, At, B1); PG8_BAR;
            PG8_LDB(B0, 1, 0); PG8_SCHED; PG8_LDA(At, 1, 0); PG8_STAGE(PG8_SA(0, 1), a2 + hstepA, voffA);
            PG8_WAIT_L(8); PG8_BAR; PG8_WAIT_L(0); PG8_MMA(0, 0, At, B0); PG8_BAR; PG8_SCHED;
            PG8_LDB(B1, 1, 1); PG8_STAGE(PG8_SB(1, 0), b3, voffB);
            PG8_BAR; PG8_WAIT_L(0); PG8_MMA(0, 1, At, B1); PG8_BAR;
            PG8_LDA(At, 1, 1); PG8_STAGE(PG8_SA(1, 0), a3, voffA);
            PG8_BAR; PG8_WAIT_L(0); PG8_MMA(1, 0, At, B0); PG8_BAR; PG8_SCHED;
            PG8_STAGE(PG8_SB(1, 1), b3 + hB1, voffB1);
            PG8_WAIT_V(6); PG8_BAR; PG8_MMA(1, 1, At, B1); PG8_BAR;
            }
        }
        if constexpr (ALIGN_EPI) { if (wr == 0) PG8_BAR; }
        if constexpr (!Epi::AFTER_DRAIN) { E(acc, cur, ui, wr, wc, fr, fq); S.done(cur); }
        if (!has_next) break;
#pragma unroll
        for (int a = 0; a < 2; ++a)
#pragma unroll
            for (int b = 0; b < 2; ++b)
#pragma unroll
                for (int m = 0; m < 4; ++m)
#pragma unroll
                    for (int n = 0; n < 2; ++n) acc[a][b][m][n] = (f32x4){0.f, 0.f, 0.f, 0.f};
        cur = nxt; uA = nuA; cB = nB; ++ui;
        if constexpr (ALIGN_EPI) { if (wr == 1) PG8_BAR; }
    }
    PG8_WAIT_V(0);
    if constexpr (!ALIGN_EPI) { if (wr == 0) PG8_BAR; }
    PG8_BAR;
    if constexpr (Epi::AFTER_DRAIN) { E.fused(acc, cur, wr, wc, fr, fq, lds, wid, lane); S.done(cur); }
#undef PG8_AP
#undef PG8_SA
#undef PG8_SB
#undef PG8_STAGE
#undef PG8_LDA
#undef PG8_LDB
#undef PG8_MMA
#undef PG8_WAIT_V
#undef PG8_WAIT_L
#undef PG8_BAR
#undef PG8_SCHED
}
}

constexpr int NWAVES = 8, NTHR = NWAVES * 64;
constexpr int DM = 1024, BATCH = 16, SEQ = 2048, T = BATCH * SEQ;
constexpr int NMEM = 256, TM = BATCH * NMEM;
constexpr int A_IN = 6152, B_IN = 2432;
constexpr int NA = 6144, NB0 = 2816, NB1 = 2560;
constexpr float EPS = 1e-6f;
#ifndef MK_N_LAUNCHES
#define MK_N_LAUNCHES 1
#endif

constexpr size_t MiB = 1u << 20;
constexpr size_t WS_CTL = 0, CTL_ZERO_BYTES = 1 * MiB;
constexpr size_t WS_WIF = 1 * MiB;
constexpr size_t WS_RL = 1 * MiB + 768 * 1024;
constexpr size_t WS_RS = 1 * MiB + 512 * 1024;
constexpr size_t WS_WINA = 2 * MiB, WINA_STRIDE = 12 * MiB;
constexpr size_t WS_WOUTA = 26 * MiB, WOUT_STRIDE = 3 * MiB;
constexpr size_t WS_WINB0 = 32 * MiB, WS_WINB1 = 38 * MiB;
constexpr size_t WS_WQUP = 43 * MiB, WQUP_STRIDE = 3 * MiB / 2;
constexpr size_t WS_WOUTB = 46 * MiB;
constexpr size_t WS_WKVB = 52 * MiB, WS_WMEM = 53 * MiB;
constexpr size_t WS_MK = 61 * MiB, WS_MV = 77 * MiB, MKV_STRIDE = 4 * MiB;
constexpr size_t WS_IF = 93 * MiB;
constexpr size_t WS_H = 94 * MiB;
constexpr size_t WS_QKR = 158 * MiB, WS_V = 286 * MiB, WS_G = 350 * MiB, WS_MQA = 414 * MiB, WS_HALO = 478 * MiB, WS_MEMN = 484 * MiB;
constexpr size_t WS_ZB = 190 * MiB, WS_MQB = 254 * MiB, WS_KSH = 318 * MiB, WS_VSH = 414 * MiB, WS_QLAT = 2 * MiB, WS_CKV = 478 * MiB, WS_KPE = 494 * MiB;
constexpr size_t WS_ROPE = 498 * MiB;
constexpr size_t WS_GATE = 506 * MiB;
constexpr size_t WS_SSQ = WS_GATE;
constexpr size_t WS_HALO2 = 486 * MiB;
constexpr size_t WS_SSH = 484 * MiB;
constexpr size_t WS_END = 508 * MiB;
constexpr int CW_BAR = 4096;

constexpr int RING_BYTES = 131072;
constexpr int LDS_BYTES = 163840;
constexpr int RSL_BYTES = 12288;
constexpr int CWIN_OFF = RING_BYTES + RSL_BYTES, CWIN_WAVE = 19 * 128;
static_assert(CWIN_OFF + 8 * CWIN_WAVE <= LDS_BYTES - 256, "LDS map");
constexpr int MISC_OFF = LDS_BYTES - 256;

#define GAS __attribute__((address_space(1)))
#define LAS __attribute__((address_space(3)))
typedef unsigned short bf16;
typedef unsigned v4u __attribute__((ext_vector_type(4)));
typedef unsigned v2u __attribute__((ext_vector_type(2)));
typedef float f32x4 __attribute__((ext_vector_type(4)));
typedef float f32x16 __attribute__((ext_vector_type(16)));
typedef short bf16x8 __attribute__((ext_vector_type(8)));
typedef short s16x4 __attribute__((ext_vector_type(4)));
#define LDS_WAIT() asm volatile("s_waitcnt lgkmcnt(0)" ::: "memory")
#define VM_WAIT() asm volatile("s_waitcnt vmcnt(0)" ::: "memory")
__device__ __forceinline__ float bflo(unsigned w) { return __uint_as_float(w << 16); }
__device__ __forceinline__ float bfhi(unsigned w) { return __uint_as_float(w & 0xffff0000u); }
__device__ __forceinline__ float bf2f(bf16 h) { return __uint_as_float((unsigned)h << 16); }
__device__ __forceinline__ unsigned pk2(float lo, float hi) { unsigned r; asm volatile("v_cvt_pk_bf16_f32 %0, %1, %2" : "=v"(r) : "v"(lo), "v"(hi)); return r; }
__device__ __forceinline__ float wave_sum(float v) {
#pragma unroll
    for (int o = 1; o < 64; o <<= 1) v += __shfl_xor(v, o);
    return v;
}
__device__ __forceinline__ float sigmoidf_(float x) { return __builtin_amdgcn_rcpf(1.f + __expf(-x)); }
__device__ __forceinline__ float siluf_(float x) { return x * sigmoidf_(x); }

#define XB_TMO      128
#define XB_XCNT(j)  (256  + 64 * (j))
#define XB_XSUB(j)  (1280 + 64 * (j))
#define XB_XGEN(j)  (2304 + 64 * (j))
#define XB_TOP      3328
#define XB_TOPGEN   3392
#define XCD_BAR_WORDS 3456
#define XB_SPIN_CAP (1u << 20)
__device__ __forceinline__ unsigned xb_ld(unsigned* p)              { return __hip_atomic_load(p, __ATOMIC_RELAXED, __HIP_MEMORY_SCOPE_AGENT); }
__device__ __forceinline__ unsigned xb_add(unsigned* p, unsigned v) { return __hip_atomic_fetch_add(p, v, __ATOMIC_RELAXED, __HIP_MEMORY_SCOPE_AGENT); }
__device__ __forceinline__ unsigned xb_xcc_id() { return (unsigned)__builtin_amdgcn_s_getreg((3 << 11) | 20) & 0xFu; }
#define XB_SPIN(cond, bar) do { unsigned _sp = 0; while (cond) { __builtin_amdgcn_s_sleep(1); \
    if ((++_sp & 255u) == 0u) { if (xb_ld(&(bar)[XB_TMO])) break; if (_sp > XB_SPIN_CAP) { atomicAdd(&(bar)[XB_TMO], 1u); break; } } } } while (0)
struct XcdBarrier { unsigned* bar; unsigned x; volatile LAS unsigned* st; };
__device__ __forceinline__ XcdBarrier xcd_barrier_post(unsigned* bar, volatile LAS unsigned* st) {
    XcdBarrier b; b.bar = bar; b.x = xb_xcc_id(); b.st = st;
    if (threadIdx.x == 0) (void)xb_add(&bar[XB_XCNT(b.x)], 1u);
    return b;
}
__device__ __forceinline__ void xcd_barrier_complete(unsigned* bar, unsigned x, unsigned& nloc, unsigned& nx) {
    const unsigned G = gridDim.x * gridDim.y * gridDim.z;
    unsigned sum, cnt, mine, sp = 0u;
    for (;;) {
        sum = 0u; cnt = 0u; mine = 0u;
#pragma unroll
        for (unsigned j = 0; j < 16; ++j) { const unsigned c = xb_ld(&bar[XB_XCNT(j)]); sum += c; cnt += (c > 0u) ? 1u : 0u; mine = (j == x) ? c : mine; }
        if (sum == G) break;
        __builtin_amdgcn_s_sleep(1);
        if ((++sp & 255u) == 0u) { if (xb_ld(&bar[XB_TMO])) break; if (sp > XB_SPIN_CAP) { atomicAdd(&bar[XB_TMO], 1u); break; } }
    }
    nloc = mine > 0u ? mine : 1u; nx = cnt > 0u ? cnt : 1u;
}
__device__ __forceinline__ void xcd_barrier(const XcdBarrier& b) {
    asm volatile("s_waitcnt vmcnt(0)" ::: "memory");
    __syncthreads();
    if (threadIdx.x == 0) {
        unsigned* bar = b.bar;
        __builtin_amdgcn_s_waitcnt(0);
        unsigned nloc = b.st[0], nx = b.st[1];
        if (nloc == 0u) { xcd_barrier_complete(bar, b.x, nloc, nx); b.st[0] = nloc; b.st[1] = nx; }
        const unsigned old = xb_add(&bar[XB_XSUB(b.x)], 1u);
        const unsigned gen = old / nloc;
        if (old + 1u == (gen + 1u) * nloc) {
            __builtin_amdgcn_fence(__ATOMIC_RELEASE, "agent");
            asm volatile("s_waitcnt vmcnt(0)" ::: "memory");
            const unsigned og = xb_add(&bar[XB_TOP], 1u);
            const unsigned tg = og / nx;
            if (og + 1u == (tg + 1u) * nx) xb_add(&bar[XB_TOPGEN], 1u);
            else XB_SPIN(xb_ld(&bar[XB_TOPGEN]) == tg, bar);
            __builtin_amdgcn_fence(__ATOMIC_ACQUIRE, "agent");
            xb_add(&bar[XB_XGEN(b.x)], 1u);
            asm volatile("s_waitcnt vmcnt(0)" ::: "memory");
        } else {
            XB_SPIN(xb_ld(&bar[XB_XGEN(b.x)]) == gen, bar);
            __builtin_amdgcn_fence(__ATOMIC_ACQUIRE, "agent");
            asm volatile("s_waitcnt vmcnt(0)" ::: "memory");
        }
    }
    __syncthreads();
}

struct Args { const float* in[26]; float* out; unsigned char* ws; int ph_lo, ph_hi; };
enum { I_X = 0, I_MEM, I_POS, I_ANORM, I_AWIN, I_ACONVW, I_ACONVB, I_AIGB, I_AFGB, I_AHNORM, I_AWOUT, I_BNORM, I_BWIN, I_BQLATN, I_BWQUP, I_BQGAIN, I_BWOUT,
       I_KVNORM, I_WKVA, I_KVLATN, I_WKVB, I_KGAIN, I_MEMNORM, I_MEMWKV, I_MEMQG, I_MEMKG };

struct TJob { const float* W; int ldw, K; const float* gain; int gain_n; bf16* dst; int nd; int kind; };
__device__ __forceinline__ int tj_srccol(int kind, int d) {
    if (kind == 1) { if (d < 3072) return d; if (d < 5120) { const int e = d - 3072; return (((e >> 5) & 1) ? 4096 : 3072) + (e >> 8) * 128 + ((e >> 6) & 3) * 32 + (e & 31); } return d + 8; }
    if (kind == 2) return d < 2048 ? d + 384 : d - 2048;
    return d;
}
constexpr int N_TJOBS = 18;
__device__ __forceinline__ TJob tjob(int j, const __attribute__((address_space(4))) Args* ap) {
    unsigned char* ws = ap->ws; TJob t;
    if (j < 2)       { t = TJob{ap->in[I_AWIN] + (size_t)j * DM * A_IN, A_IN, DM, ap->in[I_ANORM] + j * DM, DM, (bf16*)(ws + WS_WINA + j * WINA_STRIDE), NA, 1}; }
    else if (j < 4)  { const int l = j - 2; t = TJob{ap->in[I_AWOUT] + (size_t)l * 1536 * DM, DM, 1536, ap->in[I_AHNORM] + l * DM, DM, (bf16*)(ws + WS_WOUTA + l * WOUT_STRIDE), DM, 0}; }
    else if (j == 4) { t = TJob{ap->in[I_BWIN], B_IN, DM, ap->in[I_BNORM], DM, (bf16*)(ws + WS_WINB0), B_IN, 2}; }
    else if (j == 5) { t = TJob{ap->in[I_WKVA], 320, DM, ap->in[I_KVNORM], DM, (bf16*)(ws + WS_WINB0) + (size_t)B_IN * DM, 320, 0}; }
    else if (j == 6) { t = TJob{ap->in[I_WKVA], 320, DM, nullptr, 0, (bf16*)(ws + WS_WINB0) + (size_t)(B_IN + 320) * DM, NB0 - B_IN - 320, 3}; }
    else if (j == 7) { t = TJob{ap->in[I_BWIN] + (size_t)DM * B_IN, B_IN, DM, ap->in[I_BNORM] + DM, DM, (bf16*)(ws + WS_WINB1), B_IN, 2}; }
    else if (j == 8) { t = TJob{ap->in[I_WKVA], 320, DM, nullptr, 0, (bf16*)(ws + WS_WINB1) + (size_t)B_IN * DM, NB1 - B_IN, 3}; }
    else if (j < 11) { const int l = j - 9; t = TJob{ap->in[I_BWQUP] + (size_t)l * 384 * 1536, 1536, 384, ap->in[I_BQLATN] + l * 384, 384, (bf16*)(ws + WS_WQUP + l * WQUP_STRIDE), 1536, 0}; }
    else if (j < 13) { const int l = j - 11; t = TJob{ap->in[I_BWOUT] + (size_t)l * 1536 * DM, DM, 1536, nullptr, 0, (bf16*)(ws + WS_WOUTB + l * WOUT_STRIDE), DM, 0}; }
    else if (j == 13){ t = TJob{ap->in[I_WKVB], 2048, 256, ap->in[I_KVLATN], 256, (bf16*)(ws + WS_WKVB), 2048, 0}; }
    else             { const int l = j - 14; t = TJob{ap->in[I_MEMWKV] + (size_t)l * DM * DM, DM, DM, ap->in[I_MEMNORM], DM, (bf16*)(ws + WS_WMEM) + (size_t)l * DM * DM, DM, 0}; }
    return t;
}
__device__ __forceinline__ void p0_transpose_item(const TJob& J, LAS float* scr, int item, int lane) {
    const int nblk = J.nd / 32, kb = item / nblk, nb = item % nblk, k0 = 64 * kb, d0 = 32 * nb, s0 = tj_srccol(J.kind, d0);
    float tv[32];
#pragma unroll
    for (int i = 0; i < 32; ++i) { const int kk = 2 * i + (lane >> 5); tv[i] = (J.kind != 3) ? J.W[(size_t)(k0 + kk) * J.ldw + s0 + (lane & 31)] : 0.f; }
    const float gl = (J.gain && (k0 + lane) < J.gain_n) ? J.gain[k0 + lane] : 1.f;
#pragma unroll
    for (int i = 0; i < 32; ++i) { const int kk = 2 * i + (lane >> 5); scr[kk * 33 + (lane & 31)] = tv[i] * __shfl(gl, kk); }
    LDS_WAIT(); asm volatile("" ::: "memory");
    const int c = lane & 7;
#pragma unroll
    for (int j = 0; j < 4; ++j) { const int n = (lane >> 3) + 8 * j; const LAS float* s = scr + (8 * c) * 33 + n;
        v4u o; o.x = pk2(s[0 * 33], s[1 * 33]); o.y = pk2(s[2 * 33], s[3 * 33]); o.z = pk2(s[4 * 33], s[5 * 33]); o.w = pk2(s[6 * 33], s[7 * 33]);
        *(GAS v4u*)(J.dst + (size_t)(d0 + n) * J.K + k0 + 8 * c) = o; }
    LDS_WAIT(); asm volatile("" ::: "memory");
}
template <bool UNNORM> __device__ __forceinline__ void row_norm_to_bf16(const float* xrow, bf16* orow, const LAS f32x4* wif, const float* igb, const float* fgb, float* ifo, float* rs_out, int lane) {
    f32x4 v[4]; float s = 0.f;
#pragma unroll
    for (int j = 0; j < 2; ++j) { const GAS f32x4* xr = (const GAS f32x4*)(xrow + 512 * j + 8 * lane); v[2 * j] = xr[0]; v[2 * j + 1] = xr[1]; }
#pragma unroll
    for (int j = 0; j < 4; ++j) s += (v[j].x * v[j].x + v[j].y * v[j].y) + (v[j].z * v[j].z + v[j].w * v[j].w);
    const float rs = 1.0f / sqrtf(wave_sum(s) * (1.f / DM) + EPS);
    if (UNNORM) {
#pragma unroll
        for (int j = 0; j < 2; ++j) { v4u w; w.x = pk2(v[2 * j].x, v[2 * j].y); w.y = pk2(v[2 * j].z, v[2 * j].w); w.z = pk2(v[2 * j + 1].x, v[2 * j + 1].y); w.w = pk2(v[2 * j + 1].z, v[2 * j + 1].w);
            *(GAS v4u*)(orow + 512 * j + 8 * lane) = w; }
        if (lane == 8) rs_out[0] = rs;
    }
#pragma unroll
    for (int j = 0; j < 4; ++j) v[j] = v[j] * rs;
    if (!UNNORM) {
#pragma unroll
        for (int j = 0; j < 2; ++j) { v4u w; w.x = pk2(v[2 * j].x, v[2 * j].y); w.y = pk2(v[2 * j].z, v[2 * j].w); w.z = pk2(v[2 * j + 1].x, v[2 * j + 1].y); w.w = pk2(v[2 * j + 1].z, v[2 * j + 1].w);
            *(GAS v4u*)(orow + 512 * j + 8 * lane) = w; }
    }
    if (UNNORM) {
        float mine = 0.f;
#pragma unroll
        for (int g = 0; g < 8; ++g) { float d = 0.f;
#pragma unroll
            for (int j = 0; j < 2; ++j) { const f32x4 w0 = wif[((g * 2 + j) * 2 + 0) * 64 + lane], w1 = wif[((g * 2 + j) * 2 + 1) * 64 + lane];
                d += (v[2 * j].x * w0.x + v[2 * j].y * w0.y) + (v[2 * j].z * w0.z + v[2 * j].w * w0.w) + (v[2 * j + 1].x * w1.x + v[2 * j + 1].y * w1.y) + (v[2 * j + 1].z * w1.z + v[2 * j + 1].w * w1.w); }
            d = wave_sum(d); if (lane == g) mine = d; }
        if (lane < 8) ifo[lane] = mine + (lane < 4 ? igb[lane] : fgb[lane - 4]);
    }
}
__device__ __forceinline__ void wif_to_lds(LAS f32x4* img, const float* wif, int tid) {
#pragma unroll
    for (int k = 0; k < 4; ++k) { const int pc = tid + NTHR * k, ln = pc & 63, h = (pc >> 6) & 1, j = (pc >> 7) & 1, g = pc >> 8;
        img[pc] = *(const GAS f32x4*)(wif + g * DM + 512 * j + 8 * ln + 4 * h); }
    __syncthreads();
}
template <int NB> __device__ __forceinline__ void rows_gates_bf16(const bf16* X, const LAS f32x4* wif, const float* igb, const float* fgb, float* IF, float* RS, int m0, int stride, int lane) {
    v4u xw[NB][2];
#pragma unroll
    for (int i = 0; i < NB; ++i)
#pragma unroll
        for (int j = 0; j < 2; ++j) xw[i][j] = *(const GAS v4u*)(X + (size_t)(m0 + i * stride) * DM + 512 * j + 8 * lane);
#pragma unroll
    for (int i = 0; i < NB; ++i) { const int m = m0 + i * stride; f32x4 v[4]; float s = 0.f;
#pragma unroll
        for (int j = 0; j < 2; ++j) { const v4u w = xw[i][j];
            v[2 * j] = (f32x4){bflo(w.x), bfhi(w.x), bflo(w.y), bfhi(w.y)}; v[2 * j + 1] = (f32x4){bflo(w.z), bfhi(w.z), bflo(w.w), bfhi(w.w)}; }
#pragma unroll
        for (int j = 0; j < 4; ++j) s += (v[j].x * v[j].x + v[j].y * v[j].y) + (v[j].z * v[j].z + v[j].w * v[j].w);
        const float rs = 1.0f / sqrtf(wave_sum(s) * (1.f / DM) + EPS);
        if (lane == 8) RS[m] = rs;
#pragma unroll
        for (int j = 0; j < 4; ++j) v[j] = v[j] * rs;
        float mine = 0.f;
#pragma unroll
        for (int g = 0; g < 8; ++g) { float d = 0.f;
#pragma unroll
            for (int j = 0; j < 2; ++j) { const f32x4 w0 = wif[((g * 2 + j) * 2 + 0) * 64 + lane], w1 = wif[((g * 2 + j) * 2 + 1) * 64 + lane];
                d += (v[2 * j].x * w0.x + v[2 * j].y * w0.y) + (v[2 * j].z * w0.z + v[2 * j].w * w0.w) + (v[2 * j + 1].x * w1.x + v[2 * j + 1].y * w1.y) + (v[2 * j + 1].z * w1.z + v[2 * j + 1].w * w1.w); }
            d = wave_sum(d); if (lane == g) mine = d; }
        if (lane < 8) IF[(size_t)m * 8 + lane] = mine + (lane < 4 ? igb[lane] : fgb[lane - 4]); }
}
template <int NB> __device__ __forceinline__ void rows_rs384(const bf16* base, float* rs, int m0, int stride, int lane) {
    unsigned w[NB][3];
#pragma unroll
    for (int i = 0; i < NB; ++i) { const GAS unsigned* p = (const GAS unsigned*)(base + (size_t)(m0 + i * stride) * 384) + lane * 3;
#pragma unroll
        for (int q = 0; q < 3; ++q) w[i][q] = p[q]; }
#pragma unroll
    for (int i = 0; i < NB; ++i) { float s = 0.f;
#pragma unroll
        for (int q = 0; q < 3; ++q) { const float x = bflo(w[i][q]), y = bfhi(w[i][q]); s += x * x + y * y; }
        s = wave_sum(s);
        if (lane == 0) rs[m0 + i * stride] = 1.0f / sqrtf(s * (1.f / 384) + EPS); }
}
template <int E> __device__ __forceinline__ void row_scale_bf16(bf16* row, int lane) {
    static_assert(E == 4 || E == 6, "E");
    GAS unsigned* p = (GAS unsigned*)row + lane * (E / 2); unsigned w[E / 2]; float s = 0.f;
#pragma unroll
    for (int i = 0; i < E / 2; ++i) { w[i] = p[i]; const float a = bflo(w[i]), b = bfhi(w[i]); s += a * a + b * b; }
    const float rs = 1.0f / sqrtf(wave_sum(s) * (1.f / (64 * E)) + EPS);
#pragma unroll
    for (int i = 0; i < E / 2; ++i) p[i] = pk2(bflo(w[i]) * rs, bfhi(w[i]) * rs);
}
template <int NB> __device__ __forceinline__ void head128_norm4(bf16* MK, const float* gain0, int idx0, int stride, int lane) {
    v4u w[NB];
#pragma unroll
    for (int i = 0; i < NB; ++i) w[i] = *((const GAS v4u*)(MK + (size_t)(idx0 + i * stride) * 512) + lane);
#pragma unroll
    for (int i = 0; i < NB; ++i) { float x[8]; float s = 0.f; const int idx = idx0 + i * stride;
#pragma unroll
        for (int e = 0; e < 4; ++e) { x[2 * e] = bflo(w[i][e]); x[2 * e + 1] = bfhi(w[i][e]); s += x[2 * e] * x[2 * e] + x[2 * e + 1] * x[2 * e + 1]; }
        s += __shfl_xor(s, 1); s += __shfl_xor(s, 2); s += __shfl_xor(s, 4); s += __shfl_xor(s, 8);
        const float rs = 1.0f / sqrtf(s * (1.f / 128) + EPS); const float* g = gain0 + (idx >> 12) * 128 + (lane & 15) * 8; v4u o;
#pragma unroll
        for (int e = 0; e < 4; ++e) o[e] = pk2(x[2 * e] * rs * g[2 * e], x[2 * e + 1] * rs * g[2 * e + 1]);
        *((GAS v4u*)(MK + (size_t)idx * 512) + lane) = o; }
}
template <int NB> __device__ __forceinline__ void gate_rows256(bf16* HT, const bf16* Gt, int idx0, int stride, int lane, bool live) {
    v4u w[NB], gg[NB];
#pragma unroll
    for (int i = 0; i < NB; ++i) { const size_t o = (size_t)(idx0 + i * stride) * 512 + lane * 8; w[i] = *(const GAS v4u*)(HT + o); gg[i] = *(const GAS v4u*)(Gt + o); }
#pragma unroll
    for (int i = 0; i < NB; ++i) { float x[8]; float s = 0.f;
#pragma unroll
        for (int e = 0; e < 4; ++e) { x[2 * e] = bflo(w[i][e]); x[2 * e + 1] = bfhi(w[i][e]); s += x[2 * e] * x[2 * e] + x[2 * e + 1] * x[2 * e + 1]; }
        s += __shfl_xor(s, 1); s += __shfl_xor(s, 2); s += __shfl_xor(s, 4); s += __shfl_xor(s, 8); s += __shfl_xor(s, 16);
        const float rs = 1.0f / sqrtf(s * (1.f / 256) + EPS); v4u o;
#pragma unroll
        for (int e = 0; e < 4; ++e) o[e] = pk2(x[2 * e] * rs * bflo(gg[i][e]), x[2 * e + 1] * rs * bfhi(gg[i][e]));
        if (live) *(GAS v4u*)(HT + (size_t)(idx0 + i * stride) * 512 + lane * 8) = o; }
}
__device__ __forceinline__ void rope_sincos(int pos, int i, float& sn, float& cs) {
    const float invf = exp2f(-(float)i * (13.287712379549449f / 32.0f));
    const float ang = (float)pos * invf;
    const double a = (double)ang; const double n = rint(a * 0.15915494309189535); const float r = (float)(a - n * 6.283185307179586);
    sn = sinf(r); cs = cosf(r);
}
template <int NB> __device__ __forceinline__ void rope_tokens(bf16* base, const bf16* KPE, const bf16* LAT, const float* gain, const float* rt, int t0, int stride, int lane, bool live) {
    const int hh = lane >> 3, sub = lane & 7;
    v4u n0[NB], n1[NB], rp[NB]; f32x4 sc[NB][4]; float ls[NB];
#pragma unroll
    for (int i = 0; i < NB; ++i) { const int t = t0 + i * stride; const bf16* ph = base + (size_t)t * 1536 + hh * 192;
        n0[i] = *(const GAS v4u*)(ph + sub * 16); n1[i] = *(const GAS v4u*)(ph + sub * 16 + 8);
        rp[i] = KPE ? *(const GAS v4u*)(KPE + (size_t)t * 64 + sub * 8) : *(const GAS v4u*)(ph + 128 + sub * 8);
        const GAS f32x4* scp = (const GAS f32x4*)(rt + (size_t)t * 64 + (sub & 3) * 16);
#pragma unroll
        for (int q = 0; q < 4; ++q) sc[i][q] = scp[q];
        ls[i] = 0.f;
        if (LAT) { const GAS unsigned* lp = (const GAS unsigned*)(LAT + (size_t)t * 384) + lane * 3;
#pragma unroll
            for (int q = 0; q < 3; ++q) { const unsigned lw = lp[q]; const float x = bflo(lw), y = bfhi(lw); ls[i] += x * x + y * y; } } }
    float gn[16], gr[8];
#pragma unroll
    for (int q = 0; q < 4; ++q) { const f32x4 g4 = *(const GAS f32x4*)(gain + sub * 16 + 4 * q); gn[4 * q] = g4[0]; gn[4 * q + 1] = g4[1]; gn[4 * q + 2] = g4[2]; gn[4 * q + 3] = g4[3]; }
#pragma unroll
    for (int q = 0; q < 2; ++q) { const f32x4 g4 = *(const GAS f32x4*)(gain + 128 + sub * 8 + 4 * q); gr[4 * q] = g4[0]; gr[4 * q + 1] = g4[1]; gr[4 * q + 2] = g4[2]; gr[4 * q + 3] = g4[3]; }
#pragma unroll
    for (int i = 0; i < NB; ++i) { const int t = t0 + i * stride; bf16* ph = base + (size_t)t * 1536 + hh * 192;
        float xn[16], xr[8]; float s = 0.f;
#pragma unroll
        for (int e = 0; e < 4; ++e) { xn[2 * e] = bflo(n0[i][e]); xn[2 * e + 1] = bfhi(n0[i][e]); xn[8 + 2 * e] = bflo(n1[i][e]); xn[8 + 2 * e + 1] = bfhi(n1[i][e]); xr[2 * e] = bflo(rp[i][e]); xr[2 * e + 1] = bfhi(rp[i][e]); }
        float rl = 1.f;
        if (LAT) rl = 1.0f / sqrtf(wave_sum(ls[i]) * (1.f / 384) + EPS);
#pragma unroll
        for (int e = 0; e < 16; ++e) { xn[e] *= rl; s += xn[e] * xn[e]; }
#pragma unroll
        for (int e = 0; e < 8; ++e) { xr[e] *= rl; s += xr[e] * xr[e]; }
        s += __shfl_xor(s, 1); s += __shfl_xor(s, 2); s += __shfl_xor(s, 4);
        const float rs = 1.0f / sqrtf(s * (1.f / 192) + EPS);
        v4u o0, o1, o2;
#pragma unroll
        for (int e = 0; e < 4; ++e) { o0[e] = pk2(xn[2 * e] * rs * gn[2 * e], xn[2 * e + 1] * rs * gn[2 * e + 1]); o1[e] = pk2(xn[8 + 2 * e] * rs * gn[8 + 2 * e], xn[8 + 2 * e + 1] * rs * gn[8 + 2 * e + 1]); }
        float ro[8];
#pragma unroll
        for (int e = 0; e < 8; ++e) { const float own = xr[e] * rs * gr[e], oth = __shfl_xor(own, 4); const float sn = sc[i][e >> 1][(e & 1) * 2], cs = sc[i][e >> 1][(e & 1) * 2 + 1];
            ro[e] = (sub < 4) ? (own * cs - oth * sn) : (oth * sn + own * cs); }
#pragma unroll
        for (int e = 0; e < 4; ++e) o2[e] = pk2(ro[2 * e], ro[2 * e + 1]);
        if (live) { *(GAS v4u*)(ph + sub * 16) = o0; *(GAS v4u*)(ph + sub * 16 + 8) = o1; *(GAS v4u*)(ph + 128 + sub * 8) = o2; } }
}

__device__ __forceinline__ void conv_fixup(bf16* QKR, const bf16* HALO, const bf16* HALO2, const float* cw, const float* cb, int gid, bool live) {
    const int cg = gid & 255, chunk = gid >> 8, col = cg * 8;
    if (chunk >= T / 64) return;
    v4u raw[6];
#pragma unroll
    for (int i = 0; i < 3; ++i) { raw[i] = ((chunk & 31) != 0) ? *(const GAS v4u*)(HALO + ((size_t)(chunk - 1) * 3 + i) * 2048 + col) : (v4u){0u, 0u, 0u, 0u};
        raw[3 + i] = *(const GAS v4u*)(HALO2 + ((size_t)chunk * 3 + i) * 2048 + col); }
    float w[4][8], bb[8];
#pragma unroll
    for (int j = 0; j < 4; ++j) { const f32x4 a = *(const GAS f32x4*)(cw + j * 2048 + col), b = *(const GAS f32x4*)(cw + j * 2048 + col + 4);
        w[j][0] = a.x; w[j][1] = a.y; w[j][2] = a.z; w[j][3] = a.w; w[j][4] = b.x; w[j][5] = b.y; w[j][6] = b.z; w[j][7] = b.w; }
    { const f32x4 a = *(const GAS f32x4*)(cb + col), b = *(const GAS f32x4*)(cb + col + 4); bb[0] = a.x; bb[1] = a.y; bb[2] = a.z; bb[3] = a.w; bb[4] = b.x; bb[5] = b.y; bb[6] = b.z; bb[7] = b.w; }
    const float osc = (col < 1024) ? 0.0625f : 1.0f;
#pragma unroll
    for (int i = 0; i < 3; ++i) { float o[8];
#pragma unroll
        for (int e = 0; e < 8; ++e) { float acc = bb[e];
#pragma unroll
            for (int j = 0; j < 4; ++j) { const unsigned wd = raw[i + j][e >> 1]; const float xv = (e & 1) ? bfhi(wd) : bflo(wd); acc = fmaf(w[j][e], xv, acc); }
            o[e] = siluf_(acc) * osc; }
        v4u ov; ov.x = pk2(o[0], o[1]); ov.y = pk2(o[2], o[3]); ov.z = pk2(o[4], o[5]); ov.w = pk2(o[6], o[7]);
        if (live) *(GAS v4u*)(QKR + ((size_t)chunk * 64 + i) * 2048 + col) = ov; }
}

namespace pg8 {
__device__ __forceinline__ void st8(bf16_t* p, const f32x4 a, const f32x4 b) { u32x4 w; w.x = cvt_pk_bf16(a[0], a[1]); w.y = cvt_pk_bf16(a[2], a[3]); w.z = cvt_pk_bf16(b[0], b[1]); w.w = cvt_pk_bf16(b[2], b[3]); *(u32x4*)p = w; }
__device__ __forceinline__ f32x4 silu4(const f32x4 v) { f32x4 o; o[0] = siluf_(v[0]); o[1] = siluf_(v[1]); o[2] = siluf_(v[2]); o[3] = siluf_(v[3]); return o; }
__device__ __forceinline__ f32x4 ozgate4(const f32x4 o, const f32x4 z) { f32x4 r; r[0] = sigmoidf_(o[0]) * siluf_(z[0]); r[1] = sigmoidf_(o[1]) * siluf_(z[1]); r[2] = sigmoidf_(o[2]) * siluf_(z[2]); r[3] = sigmoidf_(o[3]) * siluf_(z[3]); return r; }

__device__ __forceinline__ u32x4 pack8(const f32x4 a, const f32x4 b) { u32x4 w; w.x = cvt_pk_bf16(a[0], a[1]); w.y = cvt_pk_bf16(a[2], a[3]); w.z = cvt_pk_bf16(b[0], b[1]); w.w = cvt_pk_bf16(b[2], b[3]); return w; }
__device__ __forceinline__ u32x4 swap8u(const u32x4 v) { u32x4 r;
#pragma unroll
    for (int i = 0; i < 4; ++i) r[i] = (unsigned)__builtin_amdgcn_update_dpp(0, (int)v[i], 0x128, 0xf, 0xf, false);
    return r; }
__device__ __forceinline__ void st8x2(bf16_t* p, int pitch, const u32x4 g0, const u32x4 g1, bool lo, u32x4& A, u32x4& B) {
    const u32x4 y = swap8u(lo ? g1 : g0); A = lo ? g0 : y; B = lo ? y : g1;
    *(u32x4*)p = A; *(u32x4*)(p + (size_t)8 * pitch) = B; }

struct EpiStore { static constexpr bool PERM = true, AFTER_DRAIN = false, KSCALE = false; bf16_t* O; int ldc; int live;
    __device__ __forceinline__ void operator()(const f32x4 (&acc)[2][2][4][2], const Unit& u, int ui, int wr, int wc, int fr, int fq) const {
        const bool lo = fr < 8; const int row0 = u.pm * BM + wr * 64 + (fr & 7), col0 = u.pn * BM + wc * 64 + 8 * fq + (lo ? 0 : 32);
#pragma unroll
        for (int ai = 0; ai < 2; ++ai)
#pragma unroll
            for (int m = 0; m < 4; ++m) { u32x4 A, B; if (live) st8x2(O + (size_t)(row0 + ai * HALF + m * 16) * ldc + col0, ldc, pack8(acc[ai][0][m][0], acc[ai][0][m][1]), pack8(acc[ai][1][m][0], acc[ai][1][m][1]), lo, A, B); }
    }
};
struct EpiMemKV { static constexpr bool PERM = true, AFTER_DRAIN = false, KSCALE = false; bf16_t* MK; bf16_t* MV;
    __device__ __forceinline__ void operator()(const f32x4 (&acc)[2][2][4][2], const Unit& u, int ui, int wr, int wc, int fr, int fq) const {
        const bool lo = fr < 8;
        const int l = u.pn >> 2, q = u.pn & 3; bf16_t* const mk_ = MK; const ptrdiff_t dmv_ = MV - mk_; bf16_t* base = mk_ + (q < 2 ? (ptrdiff_t)0 : dmv_) + (size_t)l * TM * 512 + (q & 1) * 256 + wc * 64 + 8 * fq + (lo ? 0 : 32);
        const int row0 = u.pm * BM + wr * 64 + (fr & 7);
#pragma unroll
        for (int ai = 0; ai < 2; ++ai)
#pragma unroll
            for (int m = 0; m < 4; ++m) { u32x4 A, B; st8x2(base + (size_t)(row0 + ai * HALF + m * 16) * 512, 512, pack8(acc[ai][0][m][0], acc[ai][0][m][1]), pack8(acc[ai][1][m][0], acc[ai][1][m][1]), lo, A, B); }
    }
};
struct EpiA { static constexpr bool PERM = true, AFTER_DRAIN = false, KSCALE = false; bf16_t *QKR, *HALO, *V, *G, *MQ; const PG8_LAS float* rsl; bf16_t* HALO2; const float* cw; const float* cb; PG8_LAS unsigned char* win;
    __device__ __forceinline__ void operator()(const f32x4 (&acc)[2][2][4][2], const Unit& u, int ui, int wr, int wc, int fr, int fq) const {
        const bool lo = fr < 8; const int pn = u.pn;
        const int rowb = u.pm * BM + wr * 64, cl = wc * 64 + 8 * fq + (lo ? 0 : 32);
        if (pn < 8) {
            asm volatile("" : "+v"(fr), "+v"(fq));
            const int f7 = fr & 7, bjq = (fr < 8) ? 0 : 1, colq = pn * 256 + wc * 64 + 8 * fq + bjq * 32;
            u32x4 gg[2][4][2];
#pragma unroll
            for (int ai = 0; ai < 2; ++ai)
#pragma unroll
                for (int m = 0; m < 4; ++m) { const float r_ = rsl[ui * 256 + wr * 64 + ai * HALF + m * 16 + fr];
                    gg[ai][m][0] = pack8(acc[ai][0][m][0] * r_, acc[ai][0][m][1] * r_); gg[ai][m][1] = pack8(acc[ai][1][m][0] * r_, acc[ai][1][m][1] * r_); }
            __builtin_amdgcn_sched_barrier(0);
            float w[4][8], bb[8];
#pragma unroll
            for (int j = 0; j < 4; ++j) { const f32x4 x = *(const f32x4*)(cw + j * 2048 + colq), y = *(const f32x4*)(cw + j * 2048 + colq + 4);
                w[j][0] = x[0]; w[j][1] = x[1]; w[j][2] = x[2]; w[j][3] = x[3]; w[j][4] = y[0]; w[j][5] = y[1]; w[j][6] = y[2]; w[j][7] = y[3]; }
            { const f32x4 x = *(const f32x4*)(cb + colq), y = *(const f32x4*)(cb + colq + 4); bb[0] = x[0]; bb[1] = x[1]; bb[2] = x[2]; bb[3] = x[3]; bb[4] = y[0]; bb[5] = y[1]; bb[6] = y[2]; bb[7] = y[3]; }
            const float osc = (pn < 4) ? 0.0625f : 1.0f;
            PG8_LAS unsigned char* wv = win + (wr * 4 + wc) * (19 * 128);
#pragma unroll
            for (int ai = 0; ai < 2; ++ai) { const int chunk = (rowb + ai * HALF) >> 6;
#pragma unroll
                for (int m = 0; m < 4; ++m) {
                    const u32x4 g0 = gg[ai][m][0], g1 = gg[ai][m][1];
                    int sw = (16 * m) % 19 + fr; sw -= (sw >= 19) ? 19 : 0;
                    *(PG8_LAS u32x4*)(wv + sw * 128 + ((fq ^ (sw & 7)) << 4)) = g0; *(PG8_LAS u32x4*)(wv + sw * 128 + (((4 + fq) ^ (sw & 7)) << 4)) = g1;
                    if (m == 3 && fr >= 13) { bf16_t* hp = HALO + ((size_t)chunk * 3 + (fr - 13)) * 2048 + pn * 256 + wc * 64 + 8 * fq; *(u32x4*)hp = g0; *(u32x4*)(hp + 32) = g1; }
                    if (m == 0 && fr < 3) { bf16_t* hp = HALO2 + ((size_t)chunk * 3 + fr) * 2048 + pn * 256 + wc * 64 + 8 * fq; *(u32x4*)hp = g0; *(u32x4*)(hp + 32) = g1; }
#pragma unroll
                    for (int hf = 0; hf < 2; ++hf) { const int rr = 16 * m + 8 * hf + f7;
                        u32x4 rw[4];
#pragma unroll
                        for (int j = 0; j < 4; ++j) { int s_ = ((16 * m + 8 * hf - j) % 19 + 19) % 19 + f7; s_ -= (s_ >= 19) ? 19 : 0;
                            rw[j] = *(const PG8_LAS u32x4*)(wv + s_ * 128 + (((bjq * 4 + fq) ^ (s_ & 7)) << 4)); }
                        float o[8];
#pragma unroll
                        for (int e = 0; e < 8; ++e) { float a_ = bb[e];
#pragma unroll
                            for (int j = 0; j < 4; ++j) { const unsigned wd = rw[j][e >> 1]; a_ = fmaf(w[3 - j][e], (e & 1) ? bfhi(wd) : bflo(wd), a_); }
                            o[e] = siluf_(a_) * osc; }
                        u32x4 ov; ov.x = cvt_pk_bf16(o[0], o[1]); ov.y = cvt_pk_bf16(o[2], o[3]); ov.z = cvt_pk_bf16(o[4], o[5]); ov.w = cvt_pk_bf16(o[6], o[7]);
                        if (!(m == 0 && hf == 0 && f7 < 3)) *(u32x4*)(QKR + (size_t)(rowb + ai * HALF + rr) * 2048 + colq) = ov;
                        __builtin_amdgcn_sched_barrier(0); }
                } }
            return;
        }
#pragma unroll
        for (int ai = 0; ai < 2; ++ai)
#pragma unroll
            for (int m = 0; m < 4; ++m) { const int rg = rowb + ai * HALF + m * 16; const size_t row = (size_t)(rg + (fr & 7)); u32x4 A, B;
                const float r_ = rsl[ui * 256 + wr * 64 + ai * HALF + m * 16 + fr];
                const f32x4 a00 = acc[ai][0][m][0] * r_, a01 = acc[ai][0][m][1] * r_, a10 = acc[ai][1][m][0] * r_, a11 = acc[ai][1][m][1] * r_;
                if (pn < 12) {
                    st8x2(V + row * 1024 + (pn - 8) * 256 + cl, 1024, pack8(a00, a01), pack8(a10, a11), lo, A, B);
                } else if (pn < 20) {
                    st8(G + (size_t)(rg + fr) * 1024 + (pn - 12) * 128 + wc * 32 + 8 * fq, ozgate4(a00, a10), ozgate4(a01, a11));
                } else if (pn < 22) {
                    st8x2(MQ + row * 1024 + (pn - 20) * 256 + cl, 1024, pack8(a00, a01), pack8(a10, a11), lo, A, B);
                } else {
                    st8x2(MQ + row * 1024 + 512 + (pn - 22) * 256 + cl, 1024, pack8(silu4(a00), silu4(a01)), pack8(silu4(a10), silu4(a11)), lo, A, B);
                }
            }
    }
};
struct EpiB { static constexpr bool PERM = true, AFTER_DRAIN = false, KSCALE = false; bf16_t *ZB, *MQ, *QLAT, *CKV, *KPE; const PG8_LAS float* rsl;
    __device__ __forceinline__ void operator()(const f32x4 (&acc)[2][2][4][2], const Unit& u, int ui, int wr, int wc, int fr, int fq) const {
        const bool lo = fr < 8; const int rowb = u.pm * BM + wr * 64 + (fr & 7);
        const int cb = u.pn * 256 + wc * 64;
        const int co = 8 * fq + (lo ? 0 : 32);
        bf16_t* dst = nullptr; int pitch = 0; bool act = false;
        if (cb < 1024) { dst = ZB + cb + co; pitch = 1024; act = true; }
        else if (cb < 1536) { dst = MQ + (cb - 1024) + co; pitch = 1024; }
        else if (cb < 2048) { dst = MQ + 512 + (cb - 1536) + co; pitch = 1024; act = true; }
        else if (cb < 2432) { dst = QLAT + (cb - 2048) + co; pitch = 384; }
        else if (CKV && cb < 2688) { dst = CKV + (cb - 2432) + co; pitch = 256; }
        else if (CKV && cb < 2752) { dst = KPE + (cb - 2688) + co; pitch = 64; }
        if (dst) {
#pragma unroll
            for (int ai = 0; ai < 2; ++ai)
#pragma unroll
                for (int m = 0; m < 4; ++m) { const size_t row = (size_t)(rowb + ai * HALF + m * 16); u32x4 A, B;
                    const float r_ = rsl[ui * 256 + wr * 64 + ai * HALF + m * 16 + fr];
                    const f32x4 a00 = acc[ai][0][m][0] * r_, a01 = acc[ai][0][m][1] * r_, a10 = acc[ai][1][m][0] * r_, a11 = acc[ai][1][m][1] * r_;
                    const u32x4 g0 = act ? pack8(silu4(a00), silu4(a01)) : pack8(a00, a01);
                    const u32x4 g1 = act ? pack8(silu4(a10), silu4(a11)) : pack8(a10, a11);
                    st8x2(dst + row * pitch, pitch, g0, g1, lo, A, B); }
        }
    }
};
struct EpiKvb { static constexpr bool PERM = true, AFTER_DRAIN = false, KSCALE = false; bf16_t *KSH, *VSH; const PG8_LAS float* rsl;
    __device__ __forceinline__ void operator()(const f32x4 (&acc)[2][2][4][2], const Unit& u, int ui, int wr, int wc, int fr, int fq) const {
        const bool lo = fr < 8; const int rowb = u.pm * BM + wr * 64 + (fr & 7), h = u.pn, co = (wc & 1) * 64 + 8 * fq + (lo ? 0 : 32);
        bf16_t* dst = (wc < 2) ? KSH + h * 192 + co : VSH + h * 128 + co; const int pitch = (wc < 2) ? 1536 : 1024;
#pragma unroll
        for (int ai = 0; ai < 2; ++ai)
#pragma unroll
            for (int m = 0; m < 4; ++m) { u32x4 A, B; const float r_ = rsl[ui * 256 + wr * 64 + ai * HALF + m * 16 + fr];
                st8x2(dst + (size_t)(rowb + ai * HALF + m * 16) * pitch, pitch, pack8(acc[ai][0][m][0] * r_, acc[ai][0][m][1] * r_), pack8(acc[ai][1][m][0] * r_, acc[ai][1][m][1] * r_), lo, A, B); }
    }
};
__device__ __forceinline__ f32x4 swap8(const f32x4 v) { f32x4 r;
#pragma unroll
    for (int i = 0; i < 4; ++i) r[i] = __int_as_float(__builtin_amdgcn_update_dpp(0, __float_as_int(v[i]), 0x128, 0xf, 0xf, false));
    return r; }
__device__ __forceinline__ float swap8f(const float v) { return __int_as_float(__builtin_amdgcn_update_dpp(0, __float_as_int(v), 0x128, 0xf, 0xf, false)); }
struct EpiResB { static constexpr bool PERM = true, AFTER_DRAIN = false, KSCALE = false; bf16_t* X; float* SSQ; int live;
    __device__ __forceinline__ void operator()(const f32x4 (&acc)[2][2][4][2], const Unit& u, int ui, int wr, int wc, int fr, int fq) const {
        const bool lo = fr < 8;
        const int row0 = u.pm * BM + wr * 64 + (fr & 7), col0 = u.pn * BM + wc * 64 + 8 * fq + (lo ? 0 : 32);
        float* sq = SSQ + (size_t)(row0 + (lo ? 0 : 8)) * 16 + u.pn * 4 + wc;
#pragma unroll
        for (int ai = 0; ai < 2; ++ai)
#pragma unroll
            for (int m = 0; m < 4; ++m) { bf16_t* p = X + (size_t)(row0 + ai * HALF + m * 16) * DM + col0;
                const f32x4 y0 = swap8(lo ? acc[ai][1][m][0] : acc[ai][0][m][0]), y1 = swap8(lo ? acc[ai][1][m][1] : acc[ai][0][m][1]);
                const f32x4 A0 = lo ? acc[ai][0][m][0] : y0, A1 = lo ? acc[ai][0][m][1] : y1, B0 = lo ? y0 : acc[ai][1][m][0], B1 = lo ? y1 : acc[ai][1][m][1];
                const u32x4 xa = *(const u32x4*)p, xb = *(const u32x4*)(p + (size_t)8 * DM);
                const f32x4 na0 = {bflo(xa.x) + A0[0], bfhi(xa.x) + A0[1], bflo(xa.y) + A0[2], bfhi(xa.y) + A0[3]}, na1 = {bflo(xa.z) + A1[0], bfhi(xa.z) + A1[1], bflo(xa.w) + A1[2], bfhi(xa.w) + A1[3]};
                const f32x4 nb0 = {bflo(xb.x) + B0[0], bfhi(xb.x) + B0[1], bflo(xb.y) + B0[2], bfhi(xb.y) + B0[3]}, nb1 = {bflo(xb.z) + B1[0], bfhi(xb.z) + B1[1], bflo(xb.w) + B1[2], bfhi(xb.w) + B1[3]};
                if (live) { *(u32x4*)p = pack8(na0, na1); *(u32x4*)(p + (size_t)8 * DM) = pack8(nb0, nb1); }
                float sA = ((na0[0] * na0[0] + na0[1] * na0[1]) + (na0[2] * na0[2] + na0[3] * na0[3])) + ((na1[0] * na1[0] + na1[1] * na1[1]) + (na1[2] * na1[2] + na1[3] * na1[3]));
                float sB = ((nb0[0] * nb0[0] + nb0[1] * nb0[1]) + (nb0[2] * nb0[2] + nb0[3] * nb0[3])) + ((nb1[0] * nb1[0] + nb1[1] * nb1[1]) + (nb1[2] * nb1[2] + nb1[3] * nb1[3]));
                sA += swap8f(sA); sB += swap8f(sB);
                sA += __shfl_xor(sA, 16); sB += __shfl_xor(sB, 16); sA += __shfl_xor(sA, 32); sB += __shfl_xor(sB, 32);
                if (fq == 0 && live) sq[(size_t)(ai * HALF + m * 16) * 16] = lo ? sA : sB; }
    }
};
struct EpiResBA : EpiResB { static constexpr bool KSCALE = true; const PG8_LAS float* ktab;
    __device__ __forceinline__ void kscale(f32x4 (&acc)[2][2][4][2], int ui, int sg, int wr, int fr) const {
        float f_[2][4];
#pragma unroll
        for (int ai = 0; ai < 2; ++ai)
#pragma unroll
            for (int m = 0; m < 4; ++m) f_[ai][m] = ktab[(ui * 256 + wr * 64 + ai * HALF + m * 16 + fr) * 4 + sg];
        __builtin_amdgcn_sched_barrier(0);
#pragma unroll
        for (int ai = 0; ai < 2; ++ai)
#pragma unroll
            for (int m = 0; m < 4; ++m)
#pragma unroll
                for (int bj = 0; bj < 2; ++bj)
#pragma unroll
                    for (int n_ = 0; n_ < 2; ++n_) acc[ai][bj][m][n_] = acc[ai][bj][m][n_] * f_[ai][m];
    }
};
struct EpiResF { static constexpr bool PERM = false, AFTER_DRAIN = false, KSCALE = false; const bf16_t* X; float* out; int live;
    __device__ __forceinline__ void operator()(const f32x4 (&acc)[2][2][4][2], const Unit& u, int ui, int wr, int wc, int fr, int fq) const {
        const bool lo = fr < 8;
        const int row0 = u.pm * BM + wr * 64 + (fr & 7), col0 = u.pn * BM + wc * 32 + 4 * fq + (lo ? 0 : 16);
#pragma unroll
        for (int ai = 0; ai < 2; ++ai)
#pragma unroll
            for (int m = 0; m < 4; ++m) { const size_t off = (size_t)(row0 + ai * HALF + m * 16) * DM + col0;
#pragma unroll
                for (int bj = 0; bj < 2; ++bj) { const f32x4 v0 = acc[ai][bj][m][0], v1 = acc[ai][bj][m][1];
                    const f32x4 y = swap8(lo ? v1 : v0);
                    const f32x4 a = lo ? v0 : y, b = lo ? y : v1;
                    const u32x2 xa = *(const u32x2*)(X + off + bj * HALF), xb = *(const u32x2*)(X + off + bj * HALF + 8 * DM);
                    const f32x4 oa = {bflo(xa.x) + a[0], bfhi(xa.x) + a[1], bflo(xa.y) + a[2], bfhi(xa.y) + a[3]}, ob = {bflo(xb.x) + b[0], bfhi(xb.x) + b[1], bflo(xb.y) + b[2], bfhi(xb.y) + b[3]};
                    if (live) { *(f32x4*)(out + off + bj * HALF) = oa; *(f32x4*)(out + off + bj * HALF + 8 * DM) = ob; } } }
    }
};
}

namespace ml {
constexpr int QP = 528, PP = 144;
constexpr int O_Q = 0, O_K = 64 * QP, O_CB = 2 * 64 * QP, O_P = 3 * 64 * QP, O_V = O_P + 64 * PP, O_H = O_V + 64 * PP, O_F = O_H + 64 * PP;
constexpr int F_U = 0, F_MT = 64, F_GT = 128, F_CL = 192, F_WA = 256, F_DEN = 320, F_QN = 384, F_N = 448, F_MISC = 704, F_NP = 712, F_WORDS = 712 + 1024;
constexpr int LDS_USED = O_F + F_WORDS * 4;
static_assert(LDS_USED <= MISC_OFF, "mLSTM LDS map");
__device__ __forceinline__ float logsigmoid_(float x) { return (x >= 0.f) ? -log1pf(expf(-x)) : x - log1pf(expf(x)); }
typedef short v4i16_t __attribute__((ext_vector_type(4)));
__device__ __forceinline__ s16x4 tr4(LAS unsigned char* p) { return __builtin_bit_cast(s16x4, __builtin_amdgcn_ds_read_tr16_b64_v4i16((LAS v4i16_t*)p)); }

__device__ __forceinline__ void gate_scan_item(const float* IFb, float* GATE, int item, int lane) {
    const int c = item & 31, h = (item >> 5) & 3, b = item >> 7; const size_t row = (size_t)b * SEQ + c * 64 + lane;
    const float ip = IFb[row * 8 + h], fp = IFb[row * 8 + 4 + h];
    float bc = logsigmoid_(fp);
#pragma unroll
    for (int o = 1; o < 64; o <<= 1) { const float t = __shfl_up(bc, o); if (lane >= o) bc += t; }
    const float u = ip - bc; float mx = u;
#pragma unroll
    for (int o = 1; o < 64; o <<= 1) { const float t = __shfl_up(mx, o); if (lane >= o) mx = fmaxf(mx, t); }
    float* g = GATE + (size_t)item * 192; g[lane] = u; g[64 + lane] = mx; g[128 + lane] = bc;
}

__device__ __forceinline__ void mlstm_item(LAS unsigned char* lds, const bf16* QK, bf16* VH, const bf16* Gt, float* SSH, const float* GATE, int b, int h, int sl, const int tid_in, const bool live) {
    int tid = tid_in; asm volatile("" : "+v"(tid));
    const int lane = tid & 63, w = __builtin_amdgcn_readfirstlane(tid >> 6), l15 = lane & 15, g = lane >> 4;
    LAS float* F = (LAS float*)(lds + O_F);
    const size_t row0 = (size_t)b * SEQ;
    const bf16* Qg = QK + row0 * 2048 + h * 256; const bf16* Kg = Qg + 1024;
    bf16* Vg = VH + row0 * 1024 + h * 256 + sl * 64; const bf16* Gg = Gt + row0 * 1024 + h * 256 + sl * 64; float* Sg = SSH + row0 * 16 + h * 4 + sl;
    const float* Gsc = GATE + (size_t)(b * 4 + h) * 32 * 192;
    const int qrow = tid >> 5, qch = tid & 31, vrow = tid >> 3, vch = tid & 7;
    v4u sq[4], sk[4], sv, sgt = (v4u){0u, 0u, 0u, 0u}; float sg_u = 0.f, sg_mx = 0.f, sg_b = 0.f;
#define ML_HSTORE(cc) do { const v4u hv_ = *(const LAS v4u*)(lds + O_H + vrow * PP + vch * 16); v4u o_; float s_ = 0.f; \
        _Pragma("unroll") for (int e_ = 0; e_ < 4; ++e_) { const float a_ = bflo(hv_[e_]), b_ = bfhi(hv_[e_]); s_ += a_ * a_ + b_ * b_; o_[e_] = pk2(a_ * bflo(sgt[e_]), b_ * bfhi(sgt[e_])); } \
        s_ += __int_as_float(__builtin_amdgcn_update_dpp(0, __float_as_int(s_), 0xB1, 0xf, 0xf, false)); s_ += __int_as_float(__builtin_amdgcn_update_dpp(0, __float_as_int(s_), 0x4E, 0xf, 0xf, false)); \
        s_ += __int_as_float(__builtin_amdgcn_update_dpp(0, __float_as_int(s_), 0x141, 0xf, 0xf, false));     \
        if (live) { *(GAS v4u*)(Vg + ((size_t)(cc) * 64 + vrow) * 1024 + vch * 8) = o_; if (vch == 0) Sg[((size_t)(cc) * 64 + vrow) * 16] = s_; } } while (0)
#define ML_LOAD(c) do { const size_t r_ = (size_t)(c) * 64; \
        _Pragma("unroll") for (int i_ = 0; i_ < 4; ++i_) { sq[i_] = *(const GAS v4u*)(Qg + (r_ + qrow + 16 * i_) * 2048 + qch * 8); sk[i_] = *(const GAS v4u*)(Kg + (r_ + qrow + 16 * i_) * 2048 + qch * 8); } \
        sv = *(const GAS v4u*)(Vg + (r_ + vrow) * 1024 + vch * 8); \
        if (w == 0) { const float* gp_ = Gsc + (size_t)(c) * 192; sg_u = gp_[lane]; sg_mx = gp_[64 + lane]; sg_b = gp_[128 + lane]; } } while (0)
    f32x4 Cst[2][4];
#pragma unroll
    for (int a = 0; a < 2; ++a)
#pragma unroll
        for (int v = 0; v < 4; ++v) Cst[a][v] = (f32x4){0.f, 0.f, 0.f, 0.f};
    float nreg = 0.f, m_run = 0.f;
    __syncthreads();
    for (int i = tid; i < 64 * QP / 4; i += NTHR) ((LAS unsigned*)(lds + O_CB))[i] = 0u;
    if (tid < 256) F[F_N + tid] = 0.f;
    ML_LOAD(0);
    for (int c = 0; c < SEQ / 64; ++c) {
#pragma unroll
        for (int i = 0; i < 4; ++i) { *(LAS v4u*)(lds + O_Q + (qrow + 16 * i) * QP + qch * 16) = sq[i]; *(LAS v4u*)(lds + O_K + (qrow + 16 * i) * QP + qch * 16) = sk[i]; }
        *(LAS v4u*)(lds + O_V + vrow * PP + vch * 16) = sv;
        if (w == 0) {
            const float Mt = fmaxf(m_run, sg_mx), Ml = __shfl(Mt, 63), bl = __shfl(sg_b, 63);
            F[F_U + lane] = sg_u; F[F_MT + lane] = Mt; F[F_GT + lane] = __expf(m_run - Mt); F[F_CL + lane] = __expf(-(sg_b + Mt)); F[F_WA + lane] = __expf(sg_u - Ml); F[F_DEN + lane] = 0.f;
            if (lane == 0) { F[F_MISC + 0] = __expf(m_run - Ml); F[F_MISC + 1] = bl + Ml; }
        }
        __syncthreads();
        if (c + 1 < SEQ / 64) ML_LOAD(c + 1);
        {
          const int tr = tid >> 3, part = tid & 7; float s = 0.f;
#pragma unroll
          for (int i = 0; i < 4; ++i) { const v4u qv = *(const LAS v4u*)(lds + O_Q + tr * QP + (part * 32 + i * 8) * 2); const LAS float* nv = F + F_N + part * 32 + i * 8;
#pragma unroll
              for (int e = 0; e < 4; ++e) { s = fmaf(bflo(qv[e]), nv[2 * e], s); s = fmaf(bfhi(qv[e]), nv[2 * e + 1], s); } }
          s += __shfl_xor(s, 1); s += __shfl_xor(s, 2); s += __shfl_xor(s, 4);
          if (part == 0) F[F_QN + tr] = s; }
        {
          const int dp = tid & 127, sq_ = tid >> 7; float s0 = 0.f, s1 = 0.f;
#pragma unroll
          for (int j = 0; j < 16; ++j) { const int s = 16 * sq_ + j; const unsigned kw = *(const LAS unsigned*)(lds + O_K + s * QP + dp * 4); const float wa = F[F_WA + s]; s0 = fmaf(wa, bflo(kw), s0); s1 = fmaf(wa, bfhi(kw), s1); }
          F[F_NP + sq_ * 256 + 2 * dp] = s0; F[F_NP + sq_ * 256 + 2 * dp + 1] = s1; }
        {
          const int ti = w & 3, sp = w >> 2; const int tcol = 16 * ti + l15; const float Mt_t = F[F_MT + tcol]; float rs_part = 0.f;
#pragma unroll
          for (int q = 0; q < 2; ++q) { const int si = 2 * sp + q; v2u pw = (v2u){0u, 0u};
              if (si <= ti) {
                  f32x4 acc = (f32x4){0.f, 0.f, 0.f, 0.f};
                  bf16x8 af[8], bfr[8];
#define ST_LOAD(kk_) do { af[kk_] = *(const LAS bf16x8*)(lds + O_K + (16 * si + l15) * QP + (32 * (kk_) + 8 * g) * 2); bfr[kk_] = *(const LAS bf16x8*)(lds + O_Q + tcol * QP + (32 * (kk_) + 8 * g) * 2); } while (0)
                  ST_LOAD(0); ST_LOAD(1); ST_LOAD(2); __builtin_amdgcn_sched_barrier(0);
#pragma unroll
                  for (int kk = 0; kk < 8; ++kk) { if (kk + 3 < 8) ST_LOAD(kk + 3); __builtin_amdgcn_sched_barrier(0);
                      acc = __builtin_amdgcn_mfma_f32_16x16x32_bf16(af[kk], bfr[kk], acc, 0, 0, 0); __builtin_amdgcn_sched_barrier(0); }
#undef ST_LOAD
                  const f32x4 uu = *(const LAS f32x4*)(F + F_U + 16 * si + 4 * g);
                  float p[4];
#pragma unroll
                  for (int r = 0; r < 4; ++r) { const int s = 16 * si + 4 * g + r; const float dd = __expf(uu[r] - Mt_t); p[r] = (s <= tcol) ? acc[r] * dd : 0.f; rs_part += p[r]; }
                  pw.x = pk2(p[0], p[1]); pw.y = pk2(p[2], p[3]);
              }
              *(LAS v2u*)(lds + O_P + tcol * PP + (16 * si + 4 * g) * 2) = pw; }
          rs_part += __shfl_xor(rs_part, 16); rs_part += __shfl_xor(rs_part, 32);
          if (g == 0) __hip_atomic_fetch_add(F + F_DEN + tcol, rs_part, __ATOMIC_RELAXED, __HIP_MEMORY_SCOPE_WORKGROUP); }
        if (c > 0) ML_HSTORE(c - 1);
        sgt = *(const GAS v4u*)(Gg + ((size_t)c * 64 + vrow) * 1024 + vch * 8);
        __syncthreads();
        const int trow = (l15 >> 2), tcol4 = 4 * (l15 & 3);
        bf16x8 vfr[4][2];
#pragma unroll
        for (int vi = 0; vi < 4; ++vi)
#pragma unroll
            for (int kk = 0; kk < 2; ++kk) { const s16x4 lo = tr4(lds + O_V + (32 * kk + 8 * g + trow) * PP + (16 * vi + tcol4) * 2), hi = tr4(lds + O_V + (32 * kk + 8 * g + 4 + trow) * PP + (16 * vi + tcol4) * 2);
                vfr[vi][kk] = (bf16x8){lo[0], lo[1], lo[2], lo[3], hi[0], hi[1], hi[2], hi[3]}; }
        { const int vi = w & 3, tp = w >> 2; const int vcol = 16 * vi + l15;
          bf16x8 cf[8];
#pragma unroll
          for (int kk = 0; kk < 8; ++kk) cf[kk] = *(const LAS bf16x8*)(lds + O_CB + vcol * QP + (32 * kk + 8 * g) * 2);
          const bf16x8 vf0 = (vi == 0) ? vfr[0][0] : (vi == 1) ? vfr[1][0] : (vi == 2) ? vfr[2][0] : vfr[3][0];
          const bf16x8 vf1 = (vi == 0) ? vfr[0][1] : (vi == 1) ? vfr[1][1] : (vi == 2) ? vfr[2][1] : vfr[3][1];
#pragma unroll
          for (int q = 0; q < 2; ++q) { const int ti = 2 * tp + q; f32x4 a1 = (f32x4){0.f, 0.f, 0.f, 0.f}, a2 = (f32x4){0.f, 0.f, 0.f, 0.f};
              { const bf16x8 pf0 = *(const LAS bf16x8*)(lds + O_P + (16 * ti + l15) * PP + (8 * g) * 2), pf1 = *(const LAS bf16x8*)(lds + O_P + (16 * ti + l15) * PP + (32 + 8 * g) * 2);
                a1 = __builtin_amdgcn_mfma_f32_16x16x32_bf16(pf0, vf0, a1, 0, 0, 0); a1 = __builtin_amdgcn_mfma_f32_16x16x32_bf16(pf1, vf1, a1, 0, 0, 0); }
              { bf16x8 qf[8];
#define NQ_LOAD(kk_) qf[kk_] = *(const LAS bf16x8*)(lds + O_Q + (16 * ti + l15) * QP + (32 * (kk_) + 8 * g) * 2)
                NQ_LOAD(0); NQ_LOAD(1); NQ_LOAD(2); NQ_LOAD(3); __builtin_amdgcn_sched_barrier(0);
#pragma unroll
                for (int kk = 0; kk < 8; ++kk) { if (kk + 4 < 8) NQ_LOAD(kk + 4); __builtin_amdgcn_sched_barrier(0); a2 = __builtin_amdgcn_mfma_f32_16x16x32_bf16(qf[kk], cf[kk], a2, 0, 0, 0); __builtin_amdgcn_sched_barrier(0); }
#undef NQ_LOAD
              }
              const f32x4 gt4 = *(const LAS f32x4*)(F + F_GT + 16 * ti + 4 * g), dn4 = *(const LAS f32x4*)(F + F_DEN + 16 * ti + 4 * g), qn4 = *(const LAS f32x4*)(F + F_QN + 16 * ti + 4 * g), cl4 = *(const LAS f32x4*)(F + F_CL + 16 * ti + 4 * g);
#pragma unroll
              for (int r = 0; r < 4; ++r) { const int t = 16 * ti + 4 * g + r; const float den = dn4[r] + gt4[r] * qn4[r];
                  const float hv = (a1[r] + gt4[r] * a2[r]) * __builtin_amdgcn_rcpf(fmaxf(fabsf(den), cl4[r]));
                  *(LAS bf16*)(lds + O_H + t * PP + vcol * 2) = (bf16)(pk2(hv, hv) & 0xffffu); } } }
        const float gs = F[F_MISC + 0], m_new = F[F_MISC + 1];
        {
          f32x4 wa4[2][2];
#pragma unroll
          for (int kk = 0; kk < 2; ++kk) { wa4[kk][0] = *(const LAS f32x4*)(F + F_WA + 32 * kk + 8 * g); wa4[kk][1] = *(const LAS f32x4*)(F + F_WA + 32 * kk + 8 * g + 4); }
#pragma unroll
          for (int a = 0; a < 2; ++a) { const int d0 = 16 * (2 * w + a);
              bf16x8 kf[2];
#pragma unroll
              for (int kk = 0; kk < 2; ++kk) { const s16x4 lo = tr4(lds + O_K + (32 * kk + 8 * g + trow) * QP + (d0 + tcol4) * 2), hi = tr4(lds + O_K + (32 * kk + 8 * g + 4 + trow) * QP + (d0 + tcol4) * 2);
                  v4u pk; pk.x = pk2(bf2f((bf16)lo[0]) * wa4[kk][0][0], bf2f((bf16)lo[1]) * wa4[kk][0][1]); pk.y = pk2(bf2f((bf16)lo[2]) * wa4[kk][0][2], bf2f((bf16)lo[3]) * wa4[kk][0][3]);
                  pk.z = pk2(bf2f((bf16)hi[0]) * wa4[kk][1][0], bf2f((bf16)hi[1]) * wa4[kk][1][1]); pk.w = pk2(bf2f((bf16)hi[2]) * wa4[kk][1][2], bf2f((bf16)hi[3]) * wa4[kk][1][3]);
                  kf[kk] = *reinterpret_cast<bf16x8*>(&pk); }
#pragma unroll
              for (int vi = 0; vi < 4; ++vi) { Cst[a][vi] = Cst[a][vi] * gs;
#pragma unroll
                  for (int kk = 0; kk < 2; ++kk) Cst[a][vi] = __builtin_amdgcn_mfma_f32_16x16x32_bf16(kf[kk], vfr[vi][kk], Cst[a][vi], 0, 0, 0); } } }
        m_run = m_new;
        __syncthreads();
#pragma unroll
        for (int a = 0; a < 2; ++a)
#pragma unroll
            for (int vi = 0; vi < 4; ++vi) { v2u o; o.x = pk2(Cst[a][vi][0], Cst[a][vi][1]); o.y = pk2(Cst[a][vi][2], Cst[a][vi][3]);
                *(LAS v2u*)(lds + O_CB + (16 * vi + l15) * QP + (16 * (2 * w + a) + 4 * g) * 2) = o; }
        if (tid < 256) { nreg = gs * nreg + ((F[F_NP + tid] + F[F_NP + 256 + tid]) + (F[F_NP + 512 + tid] + F[F_NP + 768 + tid])); F[F_N + tid] = nreg; }
    }
    __syncthreads();
    ML_HSTORE(SEQ / 64 - 1);
#undef ML_LOAD
#undef ML_HSTORE
}
}

namespace at {
constexpr int NW = 8, QBLK = 32, KVBLK = 64, DV = 128;
#define SBAR() __builtin_amdgcn_sched_barrier(0)
__device__ __forceinline__ int crow(int r, int hi) { return (r & 3) + 8 * (r >> 2) + 4 * hi; }
template <int DQ> __device__ __forceinline__ int kswz(int row, int colB) { return DQ == 128 ? row * 256 + (colB ^ ((row & 7) << 4)) : row * 384 + (colB ^ (((row >> 1) & 7) << 4)); }
__device__ __forceinline__ int v_st(int k, int c) { const int kk = (k & ~0xC) | ((k & 4) << 1) | ((k & 8) >> 1); return ((kk >> 3) * 4 + (c >> 5)) * 512 + ((kk & 7) * 32 + (c & 31)) * 2; }
__device__ __forceinline__ int v_rd_base(int lane) { return ((lane & 3) << 3) | (((lane >> 2) & 3) << 6) | (((lane >> 4) & 1) << 5) | (((lane >> 5) & 1) << 8); }
constexpr int v_rd_off(int d0, int ks, int half) { return d0 * 512 + ks * 4096 + half * 2048; }
template <int OFF> __device__ __forceinline__ s16x4 tr_read(int vb) { s16x4 r; asm volatile("ds_read_b64_tr_b16 %0, %1 offset:%2" : "=&v"(r) : "v"(vb), "i"(OFF) : "memory"); return r; }
struct VF { s16x4 l0, h0, l1, h1, l2, h2, l3, h3; };
template <int D0> __device__ __forceinline__ void v_issue(VF& f, int vb) {
    f.l0 = tr_read<v_rd_off(D0, 0, 0)>(vb); f.h0 = tr_read<v_rd_off(D0, 0, 1)>(vb); f.l1 = tr_read<v_rd_off(D0, 1, 0)>(vb); f.h1 = tr_read<v_rd_off(D0, 1, 1)>(vb);
    f.l2 = tr_read<v_rd_off(D0, 2, 0)>(vb); f.h2 = tr_read<v_rd_off(D0, 2, 1)>(vb); f.l3 = tr_read<v_rd_off(D0, 3, 0)>(vb); f.h3 = tr_read<v_rd_off(D0, 3, 1)>(vb);
}
__device__ __forceinline__ void v_mma(f32x16& od, const VF& f, bf16x8 pa0, bf16x8 pa1, bf16x8 pa2, bf16x8 pa3) {
#define PK(L, H) (bf16x8){L[0], L[1], L[2], L[3], H[0], H[1], H[2], H[3]}
    od = __builtin_amdgcn_mfma_f32_32x32x16_bf16(pa0, PK(f.l0, f.h0), od, 0, 0, 0);
    od = __builtin_amdgcn_mfma_f32_32x32x16_bf16(pa1, PK(f.l1, f.h1), od, 0, 0, 0);
    od = __builtin_amdgcn_mfma_f32_32x32x16_bf16(pa2, PK(f.l2, f.h2), od, 0, 0, 0);
    od = __builtin_amdgcn_mfma_f32_32x32x16_bf16(pa3, PK(f.l3, f.h3), od, 0, 0, 0);
#undef PK
}
__device__ __forceinline__ void pv_d0(f32x16* o, int vb, bf16x8 pa0, bf16x8 pa1, bf16x8 pa2, bf16x8 pa3) {
    VF fa, fb;
    v_issue<0>(fa, vb); SBAR();
    v_issue<1>(fb, vb); asm volatile("s_waitcnt lgkmcnt(8)" ::: "memory"); SBAR(); v_mma(o[0], fa, pa0, pa1, pa2, pa3); SBAR();
    v_issue<2>(fa, vb); asm volatile("s_waitcnt lgkmcnt(8)" ::: "memory"); SBAR(); v_mma(o[1], fb, pa0, pa1, pa2, pa3); SBAR();
    v_issue<3>(fb, vb); asm volatile("s_waitcnt lgkmcnt(8)" ::: "memory"); SBAR(); v_mma(o[2], fa, pa0, pa1, pa2, pa3); SBAR();
    asm volatile("s_waitcnt lgkmcnt(0)" ::: "memory"); SBAR(); v_mma(o[3], fb, pa0, pa1, pa2, pa3);
}
template <int DQ> struct Cst { static constexpr float SCALE = DQ == 128 ? 0.088388347648318440f : 0.072168783648703220f; static constexpr float C = SCALE * 1.4426950408889634f; };
constexpr float THR = 8.f;
template <int DQ> __device__ __forceinline__ void partialSM(f32x16& p0, f32x16& p1, float& m_reg, float& mn, float& alpha) {
    constexpr float C = Cst<DQ>::C, SC = Cst<DQ>::SCALE;
    float pmax = p0[0];
#pragma unroll
    for (int r = 1; r < 16; ++r) pmax = fmaxf(pmax, p0[r]);
#pragma unroll
    for (int r = 0; r < 16; ++r) pmax = fmaxf(pmax, p1[r]);
    { auto rr = __builtin_amdgcn_permlane32_swap(__float_as_uint(pmax), __float_as_uint(pmax), false, false); pmax = fmaxf(__uint_as_float(rr[0]), __uint_as_float(rr[1])); }
    if (__builtin_expect(__all(pmax - m_reg <= THR / SC), 1)) { mn = m_reg; alpha = 1.f; }
    else { mn = fmaxf(m_reg, pmax); alpha = __builtin_amdgcn_exp2f((m_reg - mn) * C); m_reg = mn; }
    const float mnC = -mn * C;
#pragma unroll
    for (int r = 0; r < 16; ++r) p0[r] = fmaf(p0[r], C, mnC);
#pragma unroll
    for (int r = 0; r < 16; ++r) p1[r] = fmaf(p1[r], C, mnC);
#pragma unroll
    for (int r = 0; r < 16; ++r) p0[r] = __builtin_amdgcn_exp2f(p0[r]);
}
__device__ __forceinline__ void finishSM(f32x16& p0, f32x16& p1, float alpha, float& l_reg, bf16x8& pa0, bf16x8& pa1, bf16x8& pa2, bf16x8& pa3) {
#pragma unroll
    for (int r = 0; r < 16; ++r) p1[r] = __builtin_amdgcn_exp2f(p1[r]);
    float ps = 0;
#pragma unroll
    for (int r = 0; r < 16; ++r) ps += p0[r];
#pragma unroll
    for (int r = 0; r < 16; ++r) ps += p1[r];
    { auto rr = __builtin_amdgcn_permlane32_swap(__float_as_uint(ps), __float_as_uint(ps), false, false); ps = __uint_as_float(rr[0]) + __uint_as_float(rr[1]); }
    l_reg = l_reg * alpha + ps;
#define PK4(P, BASE, OUT) do { unsigned a0 = pk2(P[BASE + 0], P[BASE + 1]), a1 = pk2(P[BASE + 2], P[BASE + 3]);   \
    unsigned b0 = pk2(P[BASE + 4], P[BASE + 5]), b1 = pk2(P[BASE + 6], P[BASE + 7]);                              \
    auto r0 = __builtin_amdgcn_permlane32_swap(a0, b0, false, false); auto r1 = __builtin_amdgcn_permlane32_swap(a1, b1, false, false); \
    v4u w_ = {r0[0], r1[0], r0[1], r1[1]}; OUT = *reinterpret_cast<bf16x8*>(&w_); } while (0)
    PK4(p0, 0, pa0); PK4(p0, 8, pa1); PK4(p1, 0, pa2); PK4(p1, 8, pa3);
#undef PK4
}
template <int DQ> __device__ __forceinline__ void qkt(f32x16& p0, f32x16& p1, const char* Ks, const bf16x8* qr, const char* qlds, int r32, int hi, bool masked) {
    constexpr int NS = DQ / 16;
    p0 = f32x16{}; p1 = f32x16{};
    bf16x8 kb0[NS], kb1[NS], qf[NS];
#define QK_LOAD(d) do { const int cb_ = ((d) * 16 + hi * 8) * 2; kb0[d] = *reinterpret_cast<const bf16x8*>(Ks + kswz<DQ>(r32, cb_)); kb1[d] = *reinterpret_cast<const bf16x8*>(Ks + kswz<DQ>(32 + r32, cb_)); \
        qf[d] = ((d) < 8) ? qr[(d) < 8 ? (d) : 0] : *reinterpret_cast<const bf16x8*>(qlds + ((d) - 8) * 1024); } while (0)
    QK_LOAD(0); QK_LOAD(1); SBAR();
#pragma unroll
    for (int d0 = 0; d0 < NS; ++d0) {
        if (d0 + 2 < NS) { QK_LOAD(d0 + 2); }
        SBAR();
        p0 = __builtin_amdgcn_mfma_f32_32x32x16_bf16(kb0[d0], qf[d0], p0, 0, 0, 0);
        p1 = __builtin_amdgcn_mfma_f32_32x32x16_bf16(kb1[d0], qf[d0], p1, 0, 0, 0);
        SBAR();
    }
#undef QK_LOAD
    if (masked) {
#pragma unroll
        for (int r = 0; r < 16; ++r) { p0[r] = -1e30f; p1[r] = -1e30f; } }
}

template <int MODE, int DQ, int SDEPTH, int LDQ, int LDK, int LDV, int LDO, int DBG = 0, bool QROPE = false, bool STAG = false>
__device__ __forceinline__ void attn_unit(const bf16* Qb, const bf16* Kh, const bf16* Vh, bf16* Ob, const bf16* Gb, const float* qgain, int NT, int wlim, char* lds, const int tid_in, const bool live, const float* rlp = nullptr, const float* rtp = nullptr) {
    int tid = tid_in; asm volatile("" : "+v"(tid));
    constexpr int KCH = DQ / 8, KPT = 64 * KCH / NTHR;
    constexpr int SHM_V = KVBLK * DV * 2, SHM_K = KVBLK * DQ * 2;
    const int wid = __builtin_amdgcn_readfirstlane(tid >> 6), lane = tid & 63, r32 = lane & 31, hi = lane >> 5;
    char* V_lds = lds; char* K_lds = lds + 2 * SHM_V;
    float* ws = (float*)(lds + 2 * SHM_V + 2 * SHM_K) + wid * 64; float* li_l = ws; float* al_l = ws + 32;
    float m_reg = -1e30f, l_reg = 0; f32x16 o[4] = {}; bf16x8 qr[8];
    const bf16* Qw = Qb + (size_t)(wid * QBLK + r32) * LDQ + hi * 8;
    char* qlds = lds + 2 * SHM_V + 2 * SHM_K + 2048 + (wid * 256 + lane) * 16;
    __syncthreads();
#pragma unroll
    for (int d0 = 0; d0 < 8; ++d0) qr[d0] = *reinterpret_cast<const bf16x8*>(Qw + d0 * 16);
    if (DQ == 192 && !QROPE) {
#pragma unroll
        for (int d0 = 8; d0 < 12; ++d0) *reinterpret_cast<bf16x8*>(qlds + (d0 - 8) * 1024) = *reinterpret_cast<const bf16x8*>(Qw + d0 * 16); }
    if (DQ == 192 && QROPE) {
        bf16x8 q8[4];
#pragma unroll
        for (int d0 = 8; d0 < 12; ++d0) q8[d0 - 8] = *reinterpret_cast<const bf16x8*>(Qw + d0 * 16);
        const int trow = wid * QBLK + r32;
        const float rlv = rlp[trow];
        const GAS f32x4* scp = (const GAS f32x4*)(rtp + (size_t)trow * 64 + hi * 16);
        f32x4 sc[2][4];
#pragma unroll
        for (int dd = 0; dd < 2; ++dd)
#pragma unroll
            for (int q_ = 0; q_ < 4; ++q_) sc[dd][q_] = scp[dd * 8 + q_];
        float s = 0.f;
#pragma unroll
        for (int d0 = 0; d0 < 8; ++d0)
#pragma unroll
            for (int e = 0; e < 8; ++e) { const float x = bf2f((bf16)qr[d0][e]); s += x * x; }
#pragma unroll
        for (int d0 = 0; d0 < 4; ++d0)
#pragma unroll
            for (int e = 0; e < 8; ++e) { const float x = bf2f((bf16)q8[d0][e]); s += x * x; }
        s += __shfl_xor(s, 32);
        const float rsn = rlv / sqrtf(rlv * rlv * s * (1.f / 192) + EPS);
#pragma unroll
        for (int d0 = 0; d0 < 8; ++d0) { const GAS f32x4* gp = (const GAS f32x4*)(qgain + d0 * 16 + hi * 8); const f32x4 g0 = gp[0], g1 = gp[1]; v4u w_;
            w_[0] = pk2(bf2f((bf16)qr[d0][0]) * rsn * g0[0], bf2f((bf16)qr[d0][1]) * rsn * g0[1]); w_[1] = pk2(bf2f((bf16)qr[d0][2]) * rsn * g0[2], bf2f((bf16)qr[d0][3]) * rsn * g0[3]);
            w_[2] = pk2(bf2f((bf16)qr[d0][4]) * rsn * g1[0], bf2f((bf16)qr[d0][5]) * rsn * g1[1]); w_[3] = pk2(bf2f((bf16)qr[d0][6]) * rsn * g1[2], bf2f((bf16)qr[d0][7]) * rsn * g1[3]);
            qr[d0] = *reinterpret_cast<bf16x8*>(&w_); }
#pragma unroll
        for (int dd = 0; dd < 2; ++dd) {
            const GAS f32x4* g1p = (const GAS f32x4*)(qgain + 128 + dd * 16 + hi * 8); const GAS f32x4* g2p = (const GAS f32x4*)(qgain + 160 + dd * 16 + hi * 8);
            const f32x4 ga0 = g1p[0], ga1 = g1p[1], gb0 = g2p[0], gb1 = g2p[1]; float o1[8], o2[8];
#pragma unroll
            for (int e = 0; e < 8; ++e) { const float a = bf2f((bf16)q8[dd][e]) * rsn * (e < 4 ? ga0[e & 3] : ga1[e & 3]), b = bf2f((bf16)q8[2 + dd][e]) * rsn * (e < 4 ? gb0[e & 3] : gb1[e & 3]);
                const float sn = sc[dd][e >> 1][(e & 1) * 2], cs = sc[dd][e >> 1][(e & 1) * 2 + 1];
                o1[e] = a * cs - b * sn; o2[e] = a * sn + b * cs; }
            v4u w1_, w2_;
#pragma unroll
            for (int e = 0; e < 4; ++e) { w1_[e] = pk2(o1[2 * e], o1[2 * e + 1]); w2_[e] = pk2(o2[2 * e], o2[2 * e + 1]); }
            *reinterpret_cast<v4u*>(qlds + dd * 1024) = w1_; *reinterpret_cast<v4u*>(qlds + (2 + dd) * 1024) = w2_; }
    }
    if (MODE == 0) {
        float s = 0.f;
#pragma unroll
        for (int d0 = 0; d0 < 8; ++d0)
#pragma unroll
            for (int e = 0; e < 8; ++e) { const float x = bf2f((bf16)qr[d0][e]); s += x * x; }
        s += __shfl_xor(s, 32);
        const float rs = 1.0f / sqrtf(s * (1.f / 128) + EPS);
#pragma unroll
        for (int d0 = 0; d0 < 8; ++d0) { const float* gp = qgain + d0 * 16 + hi * 8; v4u w_;
#pragma unroll
            for (int e = 0; e < 4; ++e) w_[e] = pk2(bf2f((bf16)qr[d0][2 * e]) * rs * gp[2 * e], bf2f((bf16)qr[d0][2 * e + 1]) * rs * gp[2 * e + 1]);
            qr[d0] = *reinterpret_cast<bf16x8*>(&w_); }
    }
    const int sr = tid >> 4, sc = (tid & 15) * 8, vst0 = v_st(sr, sc), vst1 = v_st(32 + sr, sc);
    int krow[KPT], kcol[KPT];
#pragma unroll
    for (int i = 0; i < KPT; ++i) { const int id = tid + NTHR * i; krow[i] = id / KCH; kcol[i] = (id % KCH) * 8; }
    const int vb0 = (int)(uintptr_t)V_lds + v_rd_base(lane);
    struct { bf16x8 vs0, vs1, ks[KPT]; } sr_[SDEPTH];
#define SLOAD(i, k0) do { sr_[i].vs0 = *reinterpret_cast<const bf16x8*>(&Vh[(size_t)((k0) + sr) * LDV + sc]); sr_[i].vs1 = *reinterpret_cast<const bf16x8*>(&Vh[(size_t)((k0) + 32 + sr) * LDV + sc]); \
    _Pragma("unroll") for (int q_ = 0; q_ < KPT; ++q_) sr_[i].ks[q_] = *reinterpret_cast<const bf16x8*>(&Kh[(size_t)((k0) + krow[q_]) * LDK + kcol[q_]]); } while (0)
#define SWRITE(b, i) do { *(bf16x8*)(V_lds + (b) * SHM_V + vst0) = sr_[i].vs0; *(bf16x8*)(V_lds + (b) * SHM_V + vst1) = sr_[i].vs1; \
    _Pragma("unroll") for (int q_ = 0; q_ < KPT; ++q_) *(bf16x8*)(K_lds + (b) * SHM_K + kswz<DQ>(krow[q_], kcol[q_] * 2)) = sr_[i].ks[q_]; } while (0)
#define SWAIT() do { if constexpr (SDEPTH == 2) asm volatile("s_waitcnt vmcnt(%0)" :: "n"(2 + KPT) : "memory"); else asm volatile("s_waitcnt vmcnt(0)" ::: "memory"); } while (0)
#define RESC(a) do { if (__any((a) < 1.f)) { if (hi == 0) al_l[r32] = (a); asm volatile("s_waitcnt lgkmcnt(0)" ::: "memory"); \
    _Pragma("unroll") for (int d = 0; d < 4; ++d) _Pragma("unroll") for (int r = 0; r < 16; ++r) o[d][r] *= al_l[crow(r, hi)]; } } while (0)
    f32x16 p0, p1; float mn = 0.f, al = 1.f; bf16x8 pa0, pa1, pa2, pa3;
    if constexpr (STAG) {
    const int grp = wid >> 2;
    SLOAD(0, 0); asm volatile("s_waitcnt vmcnt(0)" ::: "memory"); SWRITE(0, 0); __syncthreads();
    if (grp) { if (1 < NT) SLOAD(0, KVBLK); __syncthreads(); }
    for (int j = 0; j < NT; ++j) {
        const int bsel = j & 1;
        if (!grp) { if (j + 1 < NT) SLOAD(0, (j + 1) * KVBLK); }
        SBAR(); qkt<DQ>(p0, p1, K_lds + bsel * SHM_K, qr, qlds, r32, hi, j > wlim); partialSM<DQ>(p0, p1, m_reg, mn, al);
        if (grp) { if (j + 1 < NT) { SWAIT(); SWRITE(bsel ^ 1, 0); } }
        __syncthreads();
        RESC(al); finishSM(p0, p1, al, l_reg, pa0, pa1, pa2, pa3); SBAR(); pv_d0(o, vb0 + bsel * SHM_V, pa0, pa1, pa2, pa3);
        if (!grp) { if (j + 1 < NT) { SWAIT(); SWRITE(bsel ^ 1, 0); } } else { if (j + 2 < NT) SLOAD(0, (j + 2) * KVBLK); }
        __syncthreads();
    }
    if (!grp) __syncthreads();
    } else {
    SLOAD(0, 0); asm volatile("s_waitcnt vmcnt(0)" ::: "memory"); SWRITE(0, 0); __syncthreads();
    for (int j = 0; j < NT; ++j) {
        const int bsel = j & 1;
        if (DBG != 1) { if (j + 1 < NT) SLOAD(0, (j + 1) * KVBLK); }
        SBAR();
        if (!(MODE == 1 && j > wlim)) {
        qkt<DQ>(p0, p1, K_lds + bsel * SHM_K, qr, qlds, r32, hi, false);
        if (DBG != 2) { partialSM<DQ>(p0, p1, m_reg, mn, al);
        RESC(al);
        finishSM(p0, p1, al, l_reg, pa0, pa1, pa2, pa3); SBAR(); }
        else { asm volatile("" : "+v"(p0), "+v"(p1)); v4u w0_ = {__float_as_uint(p0[0]), __float_as_uint(p0[1]), __float_as_uint(p0[2]), __float_as_uint(p0[3])}, w1_ = {__float_as_uint(p1[0]), __float_as_uint(p1[1]), __float_as_uint(p1[2]), __float_as_uint(p1[3])};
               pa0 = *reinterpret_cast<bf16x8*>(&w0_); pa1 = *reinterpret_cast<bf16x8*>(&w1_); pa2 = pa0; pa3 = pa1; }
        pv_d0(o, vb0 + bsel * SHM_V, pa0, pa1, pa2, pa3);
        }
        if (DBG != 1) { if (j + 1 < NT) { SWAIT(); SWRITE(bsel ^ 1, 0); }
        __syncthreads(); }
    }
    }
    if (hi == 0) li_l[r32] = l_reg; asm volatile("s_waitcnt lgkmcnt(0)" ::: "memory");
    float rli[16];
#pragma unroll
    for (int r = 0; r < 16; ++r) rli[r] = __builtin_amdgcn_rcpf(li_l[crow(r, hi)]);
    char* stg = lds + wid * (32 * 256);
#pragma unroll
    for (int r = 0; r < 16; ++r) { const int orow = crow(r, hi);
#pragma unroll
        for (int d0 = 0; d0 < 4; ++d0) { const float ov = o[d0][r] * rli[r]; *(bf16*)(stg + orow * 256 + (d0 * 32 + r32) * 2) = (bf16)(pk2(ov, ov) & 0xffffu); } }
    asm volatile("s_waitcnt lgkmcnt(0)" ::: "memory");
    bf16* Ow = Ob + (size_t)(wid * QBLK) * LDO; const bf16* Gw = Gb + (size_t)(wid * QBLK) * LDO;
#pragma unroll
    for (int i = 0; i < 8; ++i) { const int row = i * 4 + (lane >> 4), ch = lane & 15; const size_t off = (size_t)row * LDO + ch * 8;
        const v4u sv_ = *(const v4u*)(stg + row * 256 + ch * 16); const v4u gv_ = *(const GAS v4u*)(Gw + off); v4u ov_;
#pragma unroll
        for (int e = 0; e < 4; ++e) ov_[e] = pk2(bflo(sv_[e]) * bflo(gv_[e]), bfhi(sv_[e]) * bfhi(gv_[e]));
        if (live) *(GAS v4u*)(Ow + off) = ov_; }
#undef SLOAD
#undef SWRITE
#undef SWAIT
#undef RESC
}
#undef SBAR
}

constexpr int NPH = 19;
#ifndef REP_KIND
#define REP_KIND (-1)
#endif
#ifndef REP_N
#define REP_N 1
#endif
#ifndef PROBE_SUB
#define PROBE_SUB 0
#endif
#ifndef EXTRA_BARS
#define EXTRA_BARS 0
#endif
__device__ __forceinline__ int opq(int v) { asm volatile("" : "+s"(v)); return v; }
#ifndef EN_MASK
#define EN_MASK 0xFFFFu
#endif
#define EN(k) (((EN_MASK) >> (k)) & 1u)
template <int MODE, int NU2> __device__ __forceinline__ void rs_table(LAS float* rsl, const pg8::StaticOrder& S, const float* src, int tid) {
#pragma unroll
    for (int k = 0; k < NU2; ++k) { const int idx = tid + NTHR * k, ui = __builtin_amdgcn_readfirstlane(idx >> 8), r = idx & 255; pg8::Unit u;
        if (S.next(ui, u)) { const size_t row = (size_t)u.pm * 256 + r; float v;
            if (MODE == 0) v = src[row];
            else { const GAS f32x4* p = (const GAS f32x4*)(src + row * 16); const f32x4 a = p[0], b = p[1], c = p[2], d = p[3];
                   const float s_ = (((a.x + a.y) + (a.z + a.w)) + ((b.x + b.y) + (b.z + b.w))) + (((c.x + c.y) + (c.z + c.w)) + ((d.x + d.y) + (d.z + d.w)));
                   v = 1.0f / sqrtf(s_ * (1.f / DM) + EPS); }
            rsl[idx] = v; } }
    __syncthreads();
}
__device__ __forceinline__ void ckv_rs_table(LAS float* rsl, const pg8::StaticOrder& S, const bf16* CKV, int tid) {
    const int wv = __builtin_amdgcn_readfirstlane(tid >> 6), lane = tid & 63; pg8::Unit u;
    for (int ui = 0; S.next(ui, u); ++ui) {
#pragma unroll
        for (int st = 0; st < 8; ++st) { const int r = wv * 32 + st * 4 + (lane >> 4); const GAS v4u* p = (const GAS v4u*)(CKV + ((size_t)u.pm * 256 + r) * 256) + (lane & 15) * 2;
            const v4u a = p[0], b = p[1]; float s_ = 0.f;
#pragma unroll
            for (int e = 0; e < 4; ++e) { s_ += bflo(a[e]) * bflo(a[e]) + bfhi(a[e]) * bfhi(a[e]); s_ += bflo(b[e]) * bflo(b[e]) + bfhi(b[e]) * bfhi(b[e]); }
            s_ += __shfl_xor(s_, 1); s_ += __shfl_xor(s_, 2); s_ += __shfl_xor(s_, 4); s_ += __shfl_xor(s_, 8);
            if ((lane & 15) == 0) rsl[ui * 256 + r] = 1.0f / sqrtf(s_ * (1.f / 256) + EPS); } }
    __syncthreads();
}
__device__ __forceinline__ void hs_table(LAS float* tab, const pg8::StaticOrder& S, const float* SSH, int tid) {
    const int ui = __builtin_amdgcn_readfirstlane(tid >> 8), r = tid & 255; pg8::Unit u;
    if (S.next(ui, u)) { const GAS f32x4* p = (const GAS f32x4*)(SSH + ((size_t)u.pm * 256 + r) * 16); float rs_[4];
#pragma unroll
        for (int h_ = 0; h_ < 4; ++h_) { const f32x4 a = p[h_]; rs_[h_] = 1.0f / sqrtf(((a.x + a.y) + (a.z + a.w)) * (1.f / 256) + EPS); }
        *(LAS f32x4*)(tab + (size_t)tid * 4) = (f32x4){rs_[0] / rs_[1], rs_[1] / rs_[2], rs_[2] / rs_[3], rs_[3]}; }
    __syncthreads();
}
__global__ void __launch_bounds__(NTHR, 2) yoco_fwd(Args args) {
    extern __shared__ __attribute__((aligned(16))) unsigned char lds[];
    LAS unsigned char* L = (LAS unsigned char*)lds;
    volatile LAS unsigned* MISC = (volatile LAS unsigned*)(L + MISC_OFF);
    const int tid0 = threadIdx.x, wave0 = __builtin_amdgcn_readfirstlane(tid0 >> 6);
    if (tid0 < 64) MISC[tid0] = 0u;
    __syncthreads();
    if ((args.ph_hi - args.ph_lo) > 1) (void)xcd_barrier_post((unsigned*)(args.ws + WS_CTL) + CW_BAR, MISC + 8);

    const int ph_lo = args.ph_lo, ph_hi = args.ph_hi;
    int rep_left = REP_N - 1;
    for (int ph = ph_lo; ph < ph_hi; ++ph) {
        const __attribute__((address_space(4))) Args* ap_ = (const __attribute__((address_space(4))) Args*)__builtin_amdgcn_kernarg_segment_ptr();
        asm volatile("" : "+s"(ap_));
#define ARG_IN(i) (ap_->in[i])
        unsigned char* ws = ap_->ws;
        const float* x_in = ARG_IN(I_X); float* xo = ap_->out;
        bf16* H = (bf16*)(ws + WS_H); float* IFb = (float*)(ws + WS_IF); float* RSb = (float*)(ws + WS_RS); float* SSQb = (float*)(ws + WS_SSQ);
        bf16* QUb = (bf16*)xo;
        bf16* MKb = (bf16*)(ws + WS_MK); bf16* MVb = (bf16*)(ws + WS_MV);
        int wave = wave0, G = (int)gridDim.x, bx = (int)blockIdx.x;
        asm volatile("" : "+s"(wave), "+s"(G), "+s"(bx));
        const int vcu = (G % 8 == 0) ? (bx % 8) * (G / 8) + bx / 8 : bx;
        const int gw = vcu * NWAVES + wave, NGW = G * NWAVES;
#define PH_TID() unsigned z_; asm volatile("v_mov_b32 %0, 0" : "=v"(z_)); const int tid = wave * 64 + (int)__builtin_amdgcn_mbcnt_hi(~0u, __builtin_amdgcn_mbcnt_lo(~0u, z_)); const int lane = tid & 63; (void)lane
        int kind, l = 0;
        if (ph < 2) kind = ph;
        else if (ph < 6) { const int k = ph - 2; kind = (k < 3) ? 10 + k : 14; }
        else if (ph < 10) { l = 1; const int k = ph - 6; kind = (k < 3) ? 10 + k : 14; }
        else if (ph < 15) { const int k = ph - 10; kind = (k < 2) ? 20 + k : 21 + k; }
        else { l = 1; const int k = ph - 15; kind = (k < 2) ? 20 + k : 22 + k; }
        const int kindrep = (kind == 21) ? 11 : (kind == 25) ? 14 : (kind == 26) ? 15 : kind;
        const bool live = !(REP_N > 1 && kindrep == REP_KIND && rep_left > 0);

        if (EN(0) && kind == 0) {
            PH_TID();
            LAS float* scr = (LAS float*)(L + wave * 16384);
            int base = 0;
            for (int j = 0; j < N_TJOBS; ++j) { const TJob J = tjob(j, ap_); const int items = (J.K / 64) * (J.nd / 32);
                int first = (gw - base) % NGW; if (first < 0) first += NGW;
                for (int it = first; it < items; it += NGW) p0_transpose_item(J, scr, it, lane);
                base += items; }
            { float* wif = (float*)(ws + WS_WIF);
              for (int i = bx * NTHR + tid; i < 2 * 8 * DM; i += G * NTHR) { const int ll = i >> 13, g8 = (i >> 10) & 7, k = i & 1023;
                  wif[i] = ARG_IN(I_AWIN)[(size_t)ll * DM * A_IN + (size_t)k * A_IN + 5120 + g8] * ARG_IN(I_ANORM)[ll * DM + k]; } }
            { float* rt = (float*)(ws + WS_ROPE); const int* pos = (const int*)ARG_IN(I_POS);
              for (int i = bx * NTHR + tid; i < T * 32; i += G * NTHR) { float sn, cs; rope_sincos(pos[i >> 5], i & 31, sn, cs); rt[2 * i] = sn; rt[2 * i + 1] = cs; } }
            { bf16* MEMN = (bf16*)(ws + WS_MEMN);
              for (int m = gw; m < TM; m += NGW) row_norm_to_bf16<false>(ARG_IN(I_MEM) + (size_t)m * DM, MEMN + (size_t)m * DM, (const LAS f32x4*)nullptr, nullptr, nullptr, nullptr, nullptr, lane); }
        } else if (EN(1) && kind == 1) {
            PH_TID();
            wif_to_lds((LAS f32x4*)L, (const float*)(ws + WS_WIF), tid);
            for (int m = gw; m < T; m += NGW) row_norm_to_bf16<true>(x_in + (size_t)m * DM, H + (size_t)m * DM, (const LAS f32x4*)L, ARG_IN(I_AIGB), ARG_IN(I_AFGB), IFb + (size_t)m * 8, RSb + m, lane);
            __syncthreads();
            pg8::Gemm g{(const bf16*)(ws + WS_MEMN), (const bf16*)(ws + WS_MEMN), (const bf16*)(ws + WS_WMEM), TM, 4096, opq(DM), opq(DM), opq(DM / 64)};
            pg8::StaticOrder S; S.init(TM, 4096, G, bx); pg8::EpiMemKV E{MKb, MVb};
            pg8::gemm_phase<pg8::EpiMemKV, pg8::StaticOrder, true, true>(L, g, S, E, tid);
        } else if (EN(2) && kind == 10) {
            PH_TID();
            if (l == 0) { for (int idx = gw; idx < 4 * TM; idx += 4 * NGW) head128_norm4<4>(MKb, ARG_IN(I_MEMKG), idx, NGW, lane); }
            pg8::Gemm g{H, H, (const bf16*)(ws + WS_WINA + l * WINA_STRIDE), T, NA, opq(DM), opq(DM), opq(DM / 64)};
            pg8::StaticOrder S; S.init(T, NA, G, bx);
            if (l == 0) rs_table<0, 6>((LAS float*)(L + RING_BYTES), S, RSb, tid);
            else { wif_to_lds((LAS f32x4*)L, (const float*)(ws + WS_WIF) + 8 * DM, tid);
                   for (int m = gw; m < T; m += 4 * NGW) rows_gates_bf16<4>(H, (const LAS f32x4*)L, ARG_IN(I_AIGB) + 4, ARG_IN(I_AFGB) + 4, IFb, RSb, m, NGW, lane);
                   rs_table<1, 6>((LAS float*)(L + RING_BYTES), S, SSQb, tid); }
            pg8::EpiA E{(bf16*)(ws + WS_QKR), (bf16*)(ws + WS_HALO), (bf16*)(ws + WS_V), (bf16*)(ws + WS_G), (bf16*)(ws + WS_MQA), (const LAS float*)(L + RING_BYTES), (bf16*)(ws + WS_HALO2), ARG_IN(I_ACONVW) + l * 4 * 2048, ARG_IN(I_ACONVB) + l * 2048, L + CWIN_OFF};
#if PROBE_SUB == 7 || PROBE_SUB == 8 || PROBE_SUB == 9
            if (!live) { pg8::EpiStore E0{(bf16*)(ws + WS_QKR), PROBE_SUB == 9 ? opq(0) : 2048, opq(PROBE_SUB == 7 ? 0 : 1)}; pg8::gemm_phase<pg8::EpiStore, pg8::StaticOrder, true, true>(L, g, S, E0, tid); } else
#endif
            pg8::gemm_phase<pg8::EpiA, pg8::StaticOrder, true, true>(L, g, S, E, tid);
        } else if (EN(3) && (kind == 11 || kind == 21)) {
            PH_TID();
            const int layer = (kind == 11) ? l : 2 + l;
            bf16* MQ = (bf16*)(ws + (kind == 11 ? WS_MQA : WS_MQB));
            if (kind == 11) for (int it = gw; it < BATCH * 4 * 32; it += NGW) ml::gate_scan_item(IFb, (float*)(ws + WS_GATE), it, lane);
            if (kind == 11) { for (int gid = bx * NTHR + tid; gid < (T / 64) * 256; gid += G * NTHR) conv_fixup((bf16*)(ws + WS_QKR), (const bf16*)(ws + WS_HALO), (const bf16*)(ws + WS_HALO2), ARG_IN(I_ACONVW) + l * 4 * 2048, ARG_IN(I_ACONVB) + l * 2048, gid, true); }
            else { for (int m = gw; m < T; m += 8 * NGW) rows_rs384<8>((const bf16*)(ws + WS_QLAT), (float*)(ws + WS_RL), m, NGW, lane); }
            if (live || PROBE_SUB == 0) for (int u = vcu; u < BATCH * 4 * 8; u += G) { const int qb = u & 7, hh = (u >> 3) & 3, b = u >> 5;
                bf16* Qb = MQ + ((size_t)b * SEQ + qb * 256) * 1024 + hh * 128;
                const bf16* Kh = MKb + (size_t)layer * TM * 512 + (size_t)b * NMEM * 512 + hh * 128; const bf16* Vh = MVb + (size_t)layer * TM * 512 + (size_t)b * NMEM * 512 + hh * 128;
                at::attn_unit<0, 128, 1, 1024, 512, 512, 1024>(Qb, Kh, Vh, Qb, Qb + 512, ARG_IN(I_MEMQG) + layer * 128, 4, 3, (char*)lds, tid, live); }
            if (kind == 21) {
                __syncthreads();
                { pg8::Gemm g{(const bf16*)(ws + WS_QLAT), (const bf16*)(ws + WS_QLAT), (const bf16*)(ws + WS_WQUP + l * WQUP_STRIDE), T, 1536, opq(384), opq(384), opq(384 / 64)};
                  pg8::StaticOrder S; S.init(T, 1536, G, bx); pg8::EpiStore E{QUb, 1536, 1};
                  pg8::gemm_phase<pg8::EpiStore, pg8::StaticOrder, true, true>(L, g, S, E, tid); }
                if (l == 0) {
                  pg8::Gemm g{(const bf16*)(ws + WS_CKV), (const bf16*)(ws + WS_CKV), (const bf16*)(ws + WS_WKVB), T, 2048, opq(256), opq(256), opq(256 / 64)};
                  pg8::StaticOrder S; S.init(T, 2048, G, bx);
                  ckv_rs_table((LAS float*)(L + RING_BYTES), S, (const bf16*)(ws + WS_CKV), tid);
                  pg8::EpiKvb E{(bf16*)(ws + WS_KSH), (bf16*)(ws + WS_VSH), (const LAS float*)(L + RING_BYTES)};
                  pg8::gemm_phase<pg8::EpiKvb, pg8::StaticOrder, true, true>(L, g, S, E, tid); }
            }
        } else if (EN(4) && kind == 12) {
            PH_TID();
            for (int it = vcu; it < BATCH * 4 * 4; it += G) ml::mlstm_item(L, (const bf16*)(ws + WS_QKR), (bf16*)(ws + WS_V), (const bf16*)(ws + WS_G), (float*)(ws + WS_SSH), (const float*)(ws + WS_GATE), it >> 4, (it >> 2) & 3, it & 3, tid, live);
        } else if (EN(6) && (kind == 14 || kind == 25)) {
            PH_TID();
            const bool isA = (kind == 14);
            const bf16* A1 = (const bf16*)(ws + (isA ? WS_V : WS_ZB)); const bf16* A2 = (const bf16*)(ws + (isA ? WS_MQA : WS_MQB));
            const bf16* Wt = (const bf16*)(ws + (isA ? WS_WOUTA : WS_WOUTB) + l * WOUT_STRIDE);
            pg8::Gemm g{A1, A2, Wt, T, DM, opq(1536), opq(DM), opq(DM / 64)};
            pg8::StaticOrder S; S.init(T, DM, G, bx);
            if (!isA && l == 1) { pg8::EpiResF E{H, xo, live ? 1 : 0}; pg8::gemm_phase<pg8::EpiResF, pg8::StaticOrder, true, true>(L, g, S, E, tid); }
            else if (isA) { hs_table((LAS float*)(L + RING_BYTES), S, (const float*)(ws + WS_SSH), tid);
                            pg8::EpiResBA E{{H, SSQb, live ? 1 : 0}, (const LAS float*)(L + RING_BYTES)}; pg8::gemm_phase<pg8::EpiResBA, pg8::StaticOrder, true, true>(L, g, S, E, tid); }
            else { pg8::EpiResB E{H, SSQb, live ? 1 : 0}; pg8::gemm_phase<pg8::EpiResB, pg8::StaticOrder, true, true>(L, g, S, E, tid); }
        } else if (EN(8) && kind == 20) {
            PH_TID();
            pg8::Gemm g{H, H, (const bf16*)(ws + (l == 0 ? WS_WINB0 : WS_WINB1)), T, l == 0 ? NB0 : NB1, opq(DM), opq(DM), opq(DM / 64)};
            pg8::StaticOrder S; S.init(T, l == 0 ? NB0 : NB1, G, bx);
            rs_table<1, 3>((LAS float*)(L + RING_BYTES), S, SSQb, tid);
            pg8::EpiB E{(bf16*)(ws + WS_ZB), (bf16*)(ws + WS_MQB), (bf16*)(ws + WS_QLAT), l == 0 ? (bf16*)(ws + WS_CKV) : nullptr, (bf16*)(ws + WS_KPE), (const LAS float*)(L + RING_BYTES)};
            pg8::gemm_phase<pg8::EpiB, pg8::StaticOrder, true, true>(L, g, S, E, tid);
        } else if (EN(10) && kind == 23) {
            PH_TID();
            const float* rt = (const float*)(ws + WS_ROPE);
            for (int t = gw; t < T; t += 2 * NGW) rope_tokens<2>((bf16*)(ws + WS_KSH), (const bf16*)(ws + WS_KPE), nullptr, ARG_IN(I_KGAIN), rt, t, NGW, lane, live);
        } else if (EN(11) && kind == 24) {
            PH_TID();
            for (int v = vcu; v < 256; v += G) { const int bh = v >> 1, half = v & 1, b = bh >> 3, hh = bh & 7;
                for (int i = 3; i >= 0; --i) { const int qb = half ? (i == 0 ? 1 : i == 1 ? 2 : i == 2 ? 5 : 6) : (i == 0 ? 0 : i == 1 ? 3 : i == 2 ? 4 : 7);
                    const bf16* Qb = (const bf16*)QUb + ((size_t)b * SEQ + qb * 256) * 1536 + hh * 192;
                    const bf16* Kh = (const bf16*)(ws + WS_KSH) + (size_t)b * SEQ * 1536 + hh * 192; const bf16* Vh = (const bf16*)(ws + WS_VSH) + (size_t)b * SEQ * 1024 + hh * 128;
                    bf16* Ob = (bf16*)(ws + WS_ZB) + ((size_t)b * SEQ + qb * 256) * 1024 + hh * 128;
                    const float* rlq = (const float*)(ws + WS_RL) + ((size_t)b * SEQ + qb * 256); const float* rtq = (const float*)(ws + WS_ROPE) + ((size_t)b * SEQ + qb * 256) * 64;
#if PROBE_SUB == 21 || PROBE_SUB == 22
                    if (!live) at::attn_unit<1, 192, 1, 1536, 1536, 1024, 1024, PROBE_SUB - 20, true>(Qb, Kh, Vh, Ob, Ob, ARG_IN(I_BQGAIN) + l * 192, 4 * qb + 4, 4 * qb + (wave >> 1), (char*)lds, tid, live, rlq, rtq); else
#endif
                    at::attn_unit<1, 192, 1, 1536, 1536, 1024, 1024, 0, true>(Qb, Kh, Vh, Ob, Ob, ARG_IN(I_BQGAIN) + l * 192, 4 * qb + 4, 4 * qb + (wave >> 1), (char*)lds, tid, live, rlq, rtq); } }
        }
        if (REP_N > 1) { if (!live) { --rep_left; --ph; } else rep_left = REP_N - 1; }
        if (ph + 1 < ph_hi) { XcdBarrier bb; bb.bar = (unsigned*)(ws + WS_CTL) + CW_BAR; bb.x = xb_xcc_id(); bb.st = (volatile LAS unsigned*)(L + MISC_OFF) + 8; xcd_barrier(bb); if (EXTRA_BARS > 0 && ph == 0) for (int e_ = 0; e_ < EXTRA_BARS; ++e_) xcd_barrier(bb); }
#undef ARG_IN
#undef PH_TID
    }
}

extern "C" void kernel_launch(void* const* d_in, const int* in_sizes, int n_in, void* d_out, int out_size, void* d_ws, size_t ws_size, hipStream_t stream) {
    static int grid = 0;
    if (grid == 0) {
        if (n_in != 26 || in_sizes[0] != T * DM || out_size != T * DM || ws_size < WS_END) {
            fprintf(stderr, "kernel_launch: built for 26 inputs, x/out of %d floats, >= %zu bytes of workspace; got n_in %d, in0 %d, out %d, ws %zu; nothing launched\n", T * DM, (size_t)WS_END, n_in, n_in > 0 ? in_sizes[0] : -1, out_size, ws_size);
            grid = -1; return; }
        int dev = 0, cus = 0;
        if (hipGetDevice(&dev) != hipSuccess || hipDeviceGetAttribute(&cus, hipDeviceAttributeMultiprocessorCount, dev) != hipSuccess) { fprintf(stderr, "kernel_launch: device query failed\n"); grid = -1; return; }
        if (hipFuncSetAttribute((const void*)yoco_fwd, hipFuncAttributeMaxDynamicSharedMemorySize, LDS_BYTES) != hipSuccess) { fprintf(stderr, "kernel_launch: hipFuncSetAttribute failed\n"); grid = -1; return; }
        int per_cu = 0;
        if (hipOccupancyMaxActiveBlocksPerMultiprocessor(&per_cu, (const void*)yoco_fwd, NTHR, LDS_BYTES) != hipSuccess || per_cu < 1) fprintf(stderr, "kernel_launch: note: occupancy query reports %d per CU\n", per_cu);
        (void)hipGetLastError();
        if (cus != 256) { fprintf(stderr, "kernel_launch: built for a 256-CU device (one workgroup per CU, work dealt in multiples of 256); this device reports %d; nothing launched\n", cus); grid = -1; return; }
        grid = cus;
    }
    if (grid < 0) return;
    if (hipMemsetAsync((char*)d_ws + WS_CTL, 0, CTL_ZERO_BYTES, stream) != hipSuccess) { fprintf(stderr, "kernel_launch: memset failed\n"); return; }
    Args a{};
    for (int i = 0; i < 26; ++i) a.in[i] = (const float*)d_in[i];
    a.out = (float*)d_out; a.ws = (unsigned char*)d_ws;
    if (MK_N_LAUNCHES == 1) { a.ph_lo = 0; a.ph_hi = NPH; hipLaunchKernelGGL(yoco_fwd, dim3(grid), dim3(NTHR), LDS_BYTES, stream, a); }
    else { for (int p = 0; p < NPH; ++p) { a.ph_lo = p; a.ph_hi = p + 1; hipLaunchKernelGGL(yoco_fwd, dim3(grid), dim3(NTHR), LDS_BYTES, stream, a); } }
    const hipError_t le = hipPeekAtLastError();
    if (le != hipSuccess) fprintf(stderr, "kernel_launch: launch failed: %s\n", hipGetErrorName(le));
}
```

```cpp
#include <hip/hip_runtime.h>
#include <cstdio>
#include <cstdint>

namespace pg8 {
#define PG8_LAS __attribute__((address_space(3)))
typedef unsigned short bf16_t;
typedef short bf16x8 __attribute__((ext_vector_type(8)));
typedef float f32x4 __attribute__((ext_vector_type(4)));
typedef unsigned u32x4 __attribute__((ext_vector_type(4)));
typedef unsigned u32x2 __attribute__((ext_vector_type(2)));
constexpr int BM = 256, BK = 64, HALF = 128, HTB = HALF * BK * 2  , STAGE_BYTES = 8 * HTB, NXCD = 8, WGM = 8;

__host__ __device__ __forceinline__ int lds_byte(int r, int c) { const int st = (r >> 4) * 2 + (c >> 5), rr = r & 15, cc = c & 31, ob = rr * 64 + cc * 2; return st * 1024 + (ob ^ (((ob >> 9) & 1) << 5)); }
__host__ __device__ __forceinline__ void stage_rc(int b, int& R, int& C) { const int st = b / 1024, sb = b % 1024, swz = sb ^ (((sb >> 9) & 1) << 5); R = (st >> 1) * 16 + swz / 64; C = (st & 1) * 32 + (swz % 64) / 2; }
__host__ __device__ __forceinline__ int perm32(int rho) { const int n = rho >> 4, i = rho & 15; return 8 * (i >> 2) + 4 * n + (i & 3); }

struct Unit { int pm, pn; };
struct Gemm { const bf16_t* A; const bf16_t* A2; const bf16_t* Bt; int M, N, K, lda, ks; };

struct StaticOrder {
    int nM, nN, nwg, G, c;
    __host__ __device__ void init(int M, int N, int G_, int c_) { nM = M / BM; nN = N / BM; nwg = nM * nN; G = G_; c = c_; }
    __host__ __device__ bool next(int i, Unit& u) const {
        const long L = (long)i * G + c; if (L >= nwg) return false;
        int wgid = (int)L; { const int q = nwg / NXCD, r = nwg % NXCD, xcd = wgid % NXCD, off = wgid / NXCD; wgid = (xcd < r ? xcd * (q + 1) : r * (q + 1) + (xcd - r) * q) + off; }
        const int nig = WGM * nN, gid = wgid / nig, fm = gid * WGM, gsz = (nM - fm) < WGM ? (nM - fm) : WGM;
        u.pm = fm + ((wgid % nig) % gsz); u.pn = (wgid % nig) / gsz; return true;
    }
    __device__ __forceinline__ void a_ready(const Unit&) const {}
    __device__ __forceinline__ void done(const Unit&) const {}
};
__device__ __forceinline__ unsigned cvt_pk_bf16(float lo, float hi) { unsigned r; asm volatile("v_cvt_pk_bf16_f32 %0, %1, %2" : "=v"(r) : "v"(lo), "v"(hi)); return r; }
template <class Epi, class Sched, bool ALIGN_EPI = false, bool SP2 = false>
__device__ __forceinline__ void gemm_phase(PG8_LAS unsigned char* lds, const Gemm g, const Sched& S, const Epi& E, const int tid) {
    const int wid = __builtin_amdgcn_readfirstlane(tid >> 6), lane = tid & 63, wr = wid >> 2, wc = wid & 3, fr = lane & 15, fq = lane >> 4;
    const int K = g.K, nt = K / BK;
    unsigned voffA[2], voffB[2];
#pragma unroll
    for (int i = 0; i < 2; ++i) { int R, C; stage_rc(tid * 16 + i * 8192, R, C); const int Rb = Epi::PERM ? ((R & ~31) + perm32(R & 31)) : R;
        voffA[i] = (unsigned)(R * g.lda + C) * 2u;
        voffB[i] = (unsigned)(Rb * K + C) * 2u; }

    const size_t kstep = (size_t)(BK * 2);
    const size_t hstep = (size_t)HALF * K * 2;
    const size_t tstep = 2 * hstep;
    const size_t hB1 = hstep;
    const size_t hstepA = (size_t)HALF * g.lda * 2, tstepA = 2 * hstepA;
    const int ks = g.ks;
#define PG8_AP(uoff, tt) (Epi::SRC2 ? (((tt) < ks) ? ((const char*)g.A + (uoff) + (size_t)(tt) * kstep) : ((const char*)g.A2 + (uoff) + (size_t)((tt) - ks) * kstep)) : ((const char*)g.A + (uoff) + (size_t)(tt) * kstep))
    const unsigned ldsw = (unsigned)wid * 1024u;
    const int aoff = lds_byte(wr * 64 + fr, fq * 8), boff = lds_byte(wc * 32 + fr, fq * 8);
#define PG8_SA(b, h) (((b) * 2 + (h)) * HTB)
#define PG8_SB(b, h) ((4 + (b) * 2 + (h)) * HTB)
#define PG8_STAGE(bufoff, gbase, voff) do { _Pragma("unroll") for (int _i = 0; _i < 2; ++_i) \
        __builtin_amdgcn_global_load_lds((const unsigned*)((const char*)(gbase) + (voff)[_i]), (PG8_LAS unsigned*)(lds + (bufoff) + ldsw + _i * 8192), 16, 0, 0); } while (0)
#define PG8_LDA(dst, b, h) do { _Pragma("unroll") for (int m = 0; m < 4; ++m) _Pragma("unroll") for (int k = 0; k < 2; ++k) dst[m][k] = *(const PG8_LAS bf16x8*)(lds + PG8_SA(b, h) + aoff + m * 2048 + k * 1024); } while (0)
#define PG8_LDB(dst, b, h) do { _Pragma("unroll") for (int n = 0; n < 2; ++n) _Pragma("unroll") for (int k = 0; k < 2; ++k) dst[n][k] = *(const PG8_LAS bf16x8*)(lds + PG8_SB(b, h) + boff + n * 2048 + k * 1024); } while (0)
#define PG8_MMA(ai, bj, At, Bt) do { __builtin_amdgcn_s_setprio(1); _Pragma("unroll") for (int m = 0; m < 4; ++m) _Pragma("unroll") for (int n = 0; n < 2; ++n) _Pragma("unroll") for (int k = 0; k < 2; ++k) \
        acc[ai][bj][m][n] = __builtin_amdgcn_mfma_f32_16x16x32_bf16(Bt[n][k], At[m][k], acc[ai][bj][m][n], 0, 0, 0); __builtin_amdgcn_s_setprio(0); } while (0)
#define PG8_WAIT_V(n) asm volatile("s_waitcnt vmcnt(" #n ")" ::: "memory")
#define PG8_WAIT_L(n) asm volatile("s_waitcnt lgkmcnt(" #n ")" ::: "memory")
#define PG8_BAR __builtin_amdgcn_s_barrier()
#define PG8_SCHED __builtin_amdgcn_sched_barrier(0)
    Unit cur, nxt; int ui = 0;
    if (!S.next(0, cur)) return;
    f32x4 acc[2][2][4][2];
#pragma unroll
    for (int a = 0; a < 2; ++a)
#pragma unroll
        for (int b = 0; b < 2; ++b)
#pragma unroll
            for (int m = 0; m < 4; ++m)
#pragma unroll
                for (int n = 0; n < 2; ++n) acc[a][b][m][n] = (f32x4){0.f, 0.f, 0.f, 0.f};
    bf16x8 At[4][2], B0[2][2], B1[2][2];
    size_t uA = (size_t)cur.pm * tstepA; const char* cB = (const char*)g.Bt + (size_t)cur.pn * tstep;
    S.a_ready(cur);
    if constexpr (SP2) {
        PG8_STAGE(PG8_SB(0, 0), cB, voffB); PG8_STAGE(PG8_SB(0, 1), cB + hB1, voffB); PG8_STAGE(PG8_SA(0, 0), PG8_AP(uA, 0), voffA); PG8_STAGE(PG8_SA(0, 1), PG8_AP(uA, 0) + hstepA, voffA);
        if (wr == 1) PG8_BAR;
        PG8_WAIT_V(2); PG8_BAR;
        PG8_STAGE(PG8_SB(1, 0), cB + kstep, voffB); PG8_STAGE(PG8_SA(1, 0), PG8_AP(uA, 1), voffA); PG8_STAGE(PG8_SB(1, 1), cB + hB1 + kstep, voffB);
        PG8_WAIT_V(6); PG8_BAR;
    } else {
        PG8_STAGE(PG8_SB(0, 0), cB, voffB); PG8_STAGE(PG8_SA(0, 0), PG8_AP(uA, 0), voffA); PG8_STAGE(PG8_SB(0, 1), cB + hB1, voffB); PG8_STAGE(PG8_SA(0, 1), PG8_AP(uA, 0) + hstepA, voffA);
        if (wr == 1) PG8_BAR;
        PG8_WAIT_V(4); PG8_BAR;
        PG8_STAGE(PG8_SB(1, 0), cB + kstep, voffB); PG8_STAGE(PG8_SA(1, 0), PG8_AP(uA, 1), voffA); PG8_STAGE(PG8_SB(1, 1), cB + hB1 + kstep, voffB);
        PG8_WAIT_V(6); PG8_BAR;
    }
    for (;;) {
        const bool has_next = S.next(ui + 1, nxt);
        const size_t nuA = has_next ? (size_t)nxt.pm * tstepA : uA; const char* nB = has_next ? (const char*)g.Bt + (size_t)nxt.pn * tstep : cB;
        for (int t = 0; t < nt; t += 2) {
            const bool last = (t == nt - 2);
            const char* a1 = PG8_AP(uA, t + 1);
            const char* a2 = last ? PG8_AP(nuA, 0) : PG8_AP(uA, t + 2); const char* b2 = last ? nB : cB + (size_t)(t + 2) * kstep;
            const char* a3 = last ? PG8_AP(nuA, 1) : PG8_AP(uA, t + 3); const char* b3 = b2 + kstep;
            if (last && has_next) S.a_ready(nxt);
            if constexpr (SP2) {
            PG8_LDB(B0, 0, 0); PG8_LDB(B1, 0, 1); PG8_SCHED; PG8_LDA(At, 0, 0); PG8_STAGE(PG8_SA(1, 1), a1 + hstepA, voffA);
            PG8_WAIT_V(8); PG8_WAIT_L(0); PG8_BAR; PG8_MMA(0, 0, At, B0); PG8_MMA(0, 1, At, B1); PG8_BAR; PG8_SCHED;
            PG8_LDA(At, 0, 1); PG8_STAGE(PG8_SB(0, 0), b2, voffB); PG8_STAGE(PG8_SB(0, 1), b2 + hB1, voffB); PG8_STAGE(PG8_SA(0, 0), a2, voffA);
            PG8_WAIT_V(8); PG8_WAIT_L(0); PG8_BAR; PG8_MMA(1, 0, At, B0); PG8_MMA(1, 1, At, B1); PG8_BAR; PG8_SCHED;
            PG8_LDB(B0, 1, 0); PG8_LDB(B1, 1, 1); PG8_SCHED; PG8_LDA(At, 1, 0); PG8_STAGE(PG8_SA(0, 1), a2 + hstepA, voffA);
            PG8_WAIT_V(8); PG8_WAIT_L(0); PG8_BAR; PG8_MMA(0, 0, At, B0); PG8_MMA(0, 1, At, B1); PG8_BAR; PG8_SCHED;
            PG8_LDA(At, 1, 1); PG8_STAGE(PG8_SB(1, 0), b3, voffB); PG8_STAGE(PG8_SB(1, 1), b3 + hB1, voffB); PG8_STAGE(PG8_SA(1, 0), a3, voffA);
            PG8_WAIT_V(8); PG8_WAIT_L(0); PG8_BAR; PG8_MMA(1, 0, At, B0); PG8_MMA(1, 1, At, B1); PG8_BAR; PG8_SCHED;
            if constexpr (Epi::KSCALE) { if ((t & 3) == 2 && t < 16) E.kscale(acc, ui, t >> 2, wr, fr); }
            } else {
            PG8_LDB(B0, 0, 0); PG8_SCHED; PG8_LDA(At, 0, 0); PG8_STAGE(PG8_SA(1, 1), a1 + hstepA, voffA);
            PG8_WAIT_L(8); PG8_BAR; PG8_WAIT_L(0); PG8_MMA(0, 0, At, B0); PG8_BAR; PG8_SCHED;
            PG8_LDB(B1, 0, 1); PG8_STAGE(PG8_SB(0, 0), b2, voffB);
            PG8_BAR; PG8_WAIT_L(0); PG8_MMA(0, 1, At, B1); PG8_BAR;
            PG8_LDA(At, 0, 1); PG8_STAGE(PG8_SA(0, 0), a2, voffA);
            PG8_BAR; PG8_WAIT_L(0); PG8_MMA(1, 0, At, B0); PG8_BAR; PG8_SCHED;
            PG8_STAGE(PG8_SB(0, 1), b2 + hB1, voffB);
            PG8_WAIT_V(6); PG8_BAR; PG8_MMA(1, 1, At, B1); PG8_BAR;
            PG8_LDB(B0, 1, 0); PG8_SCHED; PG8_LDA(At, 1, 0); PG8_STAGE(PG8_SA(0, 1), a2 + hstepA, voffA);
            PG8_WAIT_L(8); PG8_BAR; PG8_WAIT_L(0); PG8_MMA(0, 0, At, B0); PG8_BAR; PG8_SCHED;
            PG8_LDB(B1, 1, 1); PG8_STAGE(PG8_SB(1, 0), b3, voffB);
            PG8_BAR; PG8_WAIT_L(0); PG8_MMA(0, 1, At, B1); PG8_BAR;
            PG8_LDA(At, 1, 1); PG8_STAGE(PG8_SA(1, 0), a3, voffA);
            PG8_BAR; PG8_WAIT_L(0); PG8_MMA(1, 0, At, B0); PG8_BAR; PG8_SCHED;
            PG8_STAGE(PG8_SB(1, 1), b3 + hB1, voffB);
            PG8_WAIT_V(6); PG8_BAR; PG8_MMA(1, 1, At, B1); PG8_BAR;
            }
        }
        if constexpr (ALIGN_EPI) { if (wr == 0) PG8_BAR; }
        if constexpr (!Epi::AFTER_DRAIN) { E(acc, cur, ui, wr, wc, fr, fq); S.done(cur); }
        if (!has_next) break;
#pragma unroll
        for (int a = 0; a < 2; ++a)
#pragma unroll
            for (int b = 0; b < 2; ++b)
#pragma unroll
                for (int m = 0; m < 4; ++m)
#pragma unroll
                    for (int n = 0; n < 2; ++n) acc[a][b][m][n] = (f32x4){0.f, 0.f, 0.f, 0.f};
        cur = nxt; uA = nuA; cB = nB; ++ui;
        if constexpr (ALIGN_EPI) { if (wr == 1) PG8_BAR; }
    }
    PG8_WAIT_V(0);
    if constexpr (!ALIGN_EPI) { if (wr == 0) PG8_BAR; }
    PG8_BAR;
    if constexpr (Epi::AFTER_DRAIN) { E.fused(acc, cur, wr, wc, fr, fq, lds, wid, lane); S.done(cur); }
#undef PG8_AP
#undef PG8_SA
#undef PG8_SB
#undef PG8_STAGE
#undef PG8_LDA
#undef PG8_LDB
#undef PG8_MMA
#undef PG8_WAIT_V
#undef PG8_WAIT_L
#undef PG8_BAR
#undef PG8_SCHED
}
}

constexpr int NWAVES = 8, NTHR = NWAVES * 64;
constexpr int DM = 1024, BATCH = 16, SEQ = 2048, T = BATCH * SEQ;
constexpr int NMEM = 256, TM = BATCH * NMEM;
constexpr int A_IN = 6152, B_IN = 2432;
constexpr int NA = 6144, NB0 = 2816, NB1 = 2560;
constexpr float EPS = 1e-6f;
#ifndef MK_N_LAUNCHES
#define MK_N_LAUNCHES 1
#endif

constexpr size_t MiB = 1u << 20;
constexpr size_t WS_CTL = 0, CTL_ZERO_BYTES = 1 * MiB;
constexpr size_t WS_WIF = 1 * MiB;
constexpr size_t WS_RL = 1 * MiB + 768 * 1024;
constexpr size_t WS_RS = 1 * MiB + 512 * 1024;
constexpr size_t WS_WINA = 2 * MiB, WINA_STRIDE = 12 * MiB;
constexpr size_t WS_WOUTA = 26 * MiB, WOUT_STRIDE = 3 * MiB;
constexpr size_t WS_WINB0 = 32 * MiB, WS_WINB1 = 38 * MiB;
constexpr size_t WS_WQUP = 43 * MiB, WQUP_STRIDE = 3 * MiB / 2;
constexpr size_t WS_WOUTB = 46 * MiB;
constexpr size_t WS_WKVB = 52 * MiB, WS_WMEM = 53 * MiB;
constexpr size_t WS_MK = 61 * MiB, WS_MV = 77 * MiB, MKV_STRIDE = 4 * MiB;
constexpr size_t WS_IF = 93 * MiB;
constexpr size_t WS_H = 94 * MiB;
constexpr size_t WS_QKR = 158 * MiB, WS_V = 286 * MiB, WS_G = 350 * MiB, WS_MQA = 414 * MiB, WS_HALO = 478 * MiB, WS_MEMN = 484 * MiB;
constexpr size_t WS_ZB = 190 * MiB, WS_MQB = 254 * MiB, WS_KSH = 318 * MiB, WS_VSH = 414 * MiB, WS_QLAT = 2 * MiB, WS_CKV = 478 * MiB, WS_KPE = 494 * MiB;
constexpr size_t WS_ROPE = 498 * MiB;
constexpr size_t WS_GATE = 506 * MiB;
constexpr size_t WS_SSQ = WS_GATE;
constexpr size_t WS_HALO2 = 486 * MiB;
constexpr size_t WS_SSH = 484 * MiB;
constexpr size_t WS_END = 508 * MiB;
constexpr int CW_BAR = 4096;

constexpr int RING_BYTES = 131072;
constexpr int LDS_BYTES = 163840;
constexpr int RSL_BYTES = 12288;
constexpr int CWIN_OFF = RING_BYTES + RSL_BYTES, CWIN_WAVE = 19 * 128;
static_assert(CWIN_OFF + 8 * CWIN_WAVE <= LDS_BYTES - 256, "LDS map");
constexpr int MISC_OFF = LDS_BYTES - 256;

#define GAS __attribute__((address_space(1)))
#define LAS __attribute__((address_space(3)))
typedef unsigned short bf16;
typedef unsigned v4u __attribute__((ext_vector_type(4)));
typedef unsigned v2u __attribute__((ext_vector_type(2)));
typedef float f32x4 __attribute__((ext_vector_type(4)));
typedef float f32x16 __attribute__((ext_vector_type(16)));
typedef short bf16x8 __attribute__((ext_vector_type(8)));
typedef short s16x4 __attribute__((ext_vector_type(4)));
#define LDS_WAIT() asm volatile("s_waitcnt lgkmcnt(0)" ::: "memory")
#define VM_WAIT() asm volatile("s_waitcnt vmcnt(0)" ::: "memory")
__device__ __forceinline__ float bflo(unsigned w) { return __uint_as_float(w << 16); }
__device__ __forceinline__ float bfhi(unsigned w) { return __uint_as_float(w & 0xffff0000u); }
__device__ __forceinline__ float bf2f(bf16 h) { return __uint_as_float((unsigned)h << 16); }
__device__ __forceinline__ unsigned pk2(float lo, float hi) { unsigned r; asm volatile("v_cvt_pk_bf16_f32 %0, %1, %2" : "=v"(r) : "v"(lo), "v"(hi)); return r; }
__device__ __forceinline__ float wave_sum(float v) {
    v += __int_as_float(__builtin_amdgcn_update_dpp(0, __float_as_int(v), 0xB1, 0xf, 0xf, false));
    v += __int_as_float(__builtin_amdgcn_update_dpp(0, __float_as_int(v), 0x4E, 0xf, 0xf, false));
    v += __int_as_float(__builtin_amdgcn_update_dpp(0, __float_as_int(v), 0x141, 0xf, 0xf, false));
    v += __int_as_float(__builtin_amdgcn_update_dpp(0, __float_as_int(v), 0x140, 0xf, 0xf, false));
    { auto r_ = __builtin_amdgcn_permlane16_swap(__float_as_uint(v), __float_as_uint(v), false, false); v = __uint_as_float(r_[0]) + __uint_as_float(r_[1]); }
    { auto r_ = __builtin_amdgcn_permlane32_swap(__float_as_uint(v), __float_as_uint(v), false, false); v = __uint_as_float(r_[0]) + __uint_as_float(r_[1]); }
    return v;
}
#define DPPF(v, ctrl) __int_as_float(__builtin_amdgcn_update_dpp(0, __float_as_int(v), ctrl, 0xf, 0xf, false))
__device__ __forceinline__ float sum8(float v) { v += DPPF(v, 0xB1); v += DPPF(v, 0x4E); v += DPPF(v, 0x141); return v; }
__device__ __forceinline__ float sum16(float v) { v = sum8(v); v += DPPF(v, 0x140); return v; }
__device__ __forceinline__ float addx16(float v) { auto r_ = __builtin_amdgcn_permlane16_swap(__float_as_uint(v), __float_as_uint(v), false, false); return __uint_as_float(r_[0]) + __uint_as_float(r_[1]); }
__device__ __forceinline__ float addx32(float v) { auto r_ = __builtin_amdgcn_permlane32_swap(__float_as_uint(v), __float_as_uint(v), false, false); return __uint_as_float(r_[0]) + __uint_as_float(r_[1]); }
__device__ __forceinline__ float sigmoidf_(float x) { return __builtin_amdgcn_rcpf(1.f + __expf(-x)); }
__device__ __forceinline__ float siluf_(float x) { return x * sigmoidf_(x); }

#define XB_TMO      128
#define XB_XCNT(j)  (256  + 64 * (j))
#define XB_XSUB(j)  (1280 + 64 * (j))
#define XB_XGEN(j)  (2304 + 64 * (j))
#define XB_TOP      3328
#define XB_TOPGEN   3392
#define XCD_BAR_WORDS 3456
#define XB_SPIN_CAP (1u << 20)
__device__ __forceinline__ unsigned xb_ld(unsigned* p)              { return __hip_atomic_load(p, __ATOMIC_RELAXED, __HIP_MEMORY_SCOPE_AGENT); }
__device__ __forceinline__ unsigned xb_add(unsigned* p, unsigned v) { return __hip_atomic_fetch_add(p, v, __ATOMIC_RELAXED, __HIP_MEMORY_SCOPE_AGENT); }
__device__ __forceinline__ unsigned xb_xcc_id() { return (unsigned)__builtin_amdgcn_s_getreg((3 << 11) | 20) & 0xFu; }
#define XB_SPIN(cond, bar) do { unsigned _sp = 0; while (cond) { __builtin_amdgcn_s_sleep(1); \
    if ((++_sp & 255u) == 0u) { if (xb_ld(&(bar)[XB_TMO])) break; if (_sp > XB_SPIN_CAP) { atomicAdd(&(bar)[XB_TMO], 1u); break; } } } } while (0)
struct XcdBarrier { unsigned* bar; unsigned x; volatile LAS unsigned* st; };
__device__ __forceinline__ XcdBarrier xcd_barrier_post(unsigned* bar, volatile LAS unsigned* st) {
    XcdBarrier b; b.bar = bar; b.x = xb_xcc_id(); b.st = st;
    if (threadIdx.x == 0) (void)xb_add(&bar[XB_XCNT(b.x)], 1u);
    return b;
}
__device__ __forceinline__ void xcd_barrier_complete(unsigned* bar, unsigned x, unsigned& nloc, unsigned& nx) {
    const unsigned G = gridDim.x * gridDim.y * gridDim.z;
    unsigned sum, cnt, mine, sp = 0u;
    for (;;) {
        sum = 0u; cnt = 0u; mine = 0u;
#pragma unroll
        for (unsigned j = 0; j < 16; ++j) { const unsigned c = xb_ld(&bar[XB_XCNT(j)]); sum += c; cnt += (c > 0u) ? 1u : 0u; mine = (j == x) ? c : mine; }
        if (sum == G) break;
        __builtin_amdgcn_s_sleep(1);
        if ((++sp & 255u) == 0u) { if (xb_ld(&bar[XB_TMO])) break; if (sp > XB_SPIN_CAP) { atomicAdd(&bar[XB_TMO], 1u); break; } }
    }
    nloc = mine > 0u ? mine : 1u; nx = cnt > 0u ? cnt : 1u;
}
__device__ __forceinline__ void xcd_barrier(const XcdBarrier& b) {
    asm volatile("s_waitcnt vmcnt(0)" ::: "memory");
    __syncthreads();
    if (threadIdx.x == 0) {
        unsigned* bar = b.bar;
        __builtin_amdgcn_s_waitcnt(0);
        unsigned nloc = b.st[0], nx = b.st[1];
        if (nloc == 0u) { xcd_barrier_complete(bar, b.x, nloc, nx); b.st[0] = nloc; b.st[1] = nx; }
        const unsigned old = xb_add(&bar[XB_XSUB(b.x)], 1u);
        const unsigned gen = old / nloc;
        if (old + 1u == (gen + 1u) * nloc) {
            __builtin_amdgcn_fence(__ATOMIC_RELEASE, "agent");
            asm volatile("s_waitcnt vmcnt(0)" ::: "memory");
            const unsigned og = xb_add(&bar[XB_TOP], 1u);
            const unsigned tg = og / nx;
            if (og + 1u == (tg + 1u) * nx) xb_add(&bar[XB_TOPGEN], 1u);
            else XB_SPIN(xb_ld(&bar[XB_TOPGEN]) == tg, bar);
            __builtin_amdgcn_fence(__ATOMIC_ACQUIRE, "agent");
            xb_add(&bar[XB_XGEN(b.x)], 1u);
            asm volatile("s_waitcnt vmcnt(0)" ::: "memory");
        } else {
            XB_SPIN(xb_ld(&bar[XB_XGEN(b.x)]) == gen, bar);
            __builtin_amdgcn_fence(__ATOMIC_ACQUIRE, "agent");
            asm volatile("s_waitcnt vmcnt(0)" ::: "memory");
        }
    }
    __syncthreads();
}

struct Args { const float* in[26]; float* out; unsigned char* ws; int ph_lo, ph_hi; };
enum { I_X = 0, I_MEM, I_POS, I_ANORM, I_AWIN, I_ACONVW, I_ACONVB, I_AIGB, I_AFGB, I_AHNORM, I_AWOUT, I_BNORM, I_BWIN, I_BQLATN, I_BWQUP, I_BQGAIN, I_BWOUT,
       I_KVNORM, I_WKVA, I_KVLATN, I_WKVB, I_KGAIN, I_MEMNORM, I_MEMWKV, I_MEMQG, I_MEMKG };

struct TJob { const float* W; int ldw, K; const float* gain; int gain_n; bf16* dst; int nd; int kind; int r0, perm; };
__device__ __forceinline__ int perm256(int r) { const int t = r & 255; return (r & ~255) | (((t >> 5) & 1) * 128 + ((t >> 6) & 3) * 32 + (t & 31)); }
__device__ __forceinline__ int tj_srccol(int kind, int d) {
    if (kind == 1) { if (d < 3072) return d; if (d < 5120) { const int e = d - 3072; return (((e >> 5) & 1) ? 4096 : 3072) + (e >> 8) * 128 + ((e >> 6) & 3) * 32 + (e & 31); } return d + 8; }
    if (kind == 2) return d < 2048 ? d + 384 : d - 2048;
    return d;
}
constexpr int N_TJOBS = 18;
__device__ __forceinline__ TJob tjob(int j, const __attribute__((address_space(4))) Args* ap) {
    unsigned char* ws = ap->ws; TJob t;
    if (j < 2)       { t = TJob{ap->in[I_AWIN] + (size_t)j * DM * A_IN, A_IN, DM, ap->in[I_ANORM] + j * DM, DM, (bf16*)(ws + WS_WINA + j * WINA_STRIDE), NA, 1, 0, 1}; }
    else if (j < 4)  { const int l = j - 2; t = TJob{ap->in[I_AWOUT] + (size_t)l * 1536 * DM, DM, 1536, ap->in[I_AHNORM] + l * DM, DM, (bf16*)(ws + WS_WOUTA + l * WOUT_STRIDE), DM, 0, 0, 1}; }
    else if (j == 4) { t = TJob{ap->in[I_BWIN], B_IN, DM, ap->in[I_BNORM], DM, (bf16*)(ws + WS_WINB0), B_IN, 2, 0, 1}; }
    else if (j == 5) { t = TJob{ap->in[I_WKVA], 320, DM, ap->in[I_KVNORM], DM, (bf16*)(ws + WS_WINB0), 320, 0, B_IN, 1}; }
    else if (j == 6) { t = TJob{ap->in[I_WKVA], 320, DM, nullptr, 0, (bf16*)(ws + WS_WINB0), NB0 - B_IN - 320, 3, B_IN + 320, 1}; }
    else if (j == 7) { t = TJob{ap->in[I_BWIN] + (size_t)DM * B_IN, B_IN, DM, ap->in[I_BNORM] + DM, DM, (bf16*)(ws + WS_WINB1), B_IN, 2, 0, 1}; }
    else if (j == 8) { t = TJob{ap->in[I_WKVA], 320, DM, nullptr, 0, (bf16*)(ws + WS_WINB1), NB1 - B_IN, 3, B_IN, 1}; }
    else if (j < 11) { const int l = j - 9; t = TJob{ap->in[I_BWQUP] + (size_t)l * 384 * 1536, 1536, 384, ap->in[I_BQLATN] + l * 384, 384, (bf16*)(ws + WS_WQUP + l * WQUP_STRIDE), 1536, 0, 0, 1}; }
    else if (j < 13) { const int l = j - 11; t = TJob{ap->in[I_BWOUT] + (size_t)l * 1536 * DM, DM, 1536, nullptr, 0, (bf16*)(ws + WS_WOUTB + l * WOUT_STRIDE), DM, 0, 0, l == 0 ? 1 : 0}; }
    else if (j == 13){ t = TJob{ap->in[I_WKVB], 2048, 256, ap->in[I_KVLATN], 256, (bf16*)(ws + WS_WKVB), 2048, 0, 0, 1}; }
    else             { const int l = j - 14; t = TJob{ap->in[I_MEMWKV] + (size_t)l * DM * DM, DM, DM, ap->in[I_MEMNORM], DM, (bf16*)(ws + WS_WMEM), DM, 0, l * DM, 1}; }
    return t;
}
__device__ __forceinline__ void p0_transpose_item(const TJob& J, LAS float* scr, int item, int lane) {
    const int nblk = J.nd / 32, kb = item / nblk, nb = item % nblk, k0 = 64 * kb, d0 = 32 * nb, s0 = tj_srccol(J.kind, d0);
    float tv[32];
#pragma unroll
    for (int i = 0; i < 32; ++i) { const int kk = 2 * i + (lane >> 5); tv[i] = (J.kind != 3) ? J.W[(size_t)(k0 + kk) * J.ldw + s0 + (lane & 31)] : 0.f; }
    const float gl = (J.gain && (k0 + lane) < J.gain_n) ? J.gain[k0 + lane] : 1.f;
#pragma unroll
    for (int i = 0; i < 32; ++i) { const int kk = 2 * i + (lane >> 5); scr[kk * 33 + (lane & 31)] = tv[i] * __shfl(gl, kk); }
    LDS_WAIT(); asm volatile("" ::: "memory");
    const int c = lane & 7;
#pragma unroll
    for (int j = 0; j < 4; ++j) { const int n = (lane >> 3) + 8 * j; const LAS float* s = scr + (8 * c) * 33 + n;
        v4u o; o.x = pk2(s[0 * 33], s[1 * 33]); o.y = pk2(s[2 * 33], s[3 * 33]); o.z = pk2(s[4 * 33], s[5 * 33]); o.w = pk2(s[6 * 33], s[7 * 33]);
        const int row_ = J.r0 + d0 + n; *(GAS v4u*)(J.dst + (size_t)(J.perm ? perm256(row_) : row_) * J.K + k0 + 8 * c) = o; }
    LDS_WAIT(); asm volatile("" ::: "memory");
}
template <bool UNNORM> __device__ __forceinline__ void row_norm_to_bf16(const float* xrow, bf16* orow, const LAS f32x4* wif, const float* igb, const float* fgb, float* ifo, float* rs_out, int lane) {
    f32x4 v[4]; float s = 0.f;
#pragma unroll
    for (int j = 0; j < 2; ++j) { const GAS f32x4* xr = (const GAS f32x4*)(xrow + 512 * j + 8 * lane); v[2 * j] = xr[0]; v[2 * j + 1] = xr[1]; }
#pragma unroll
    for (int j = 0; j < 4; ++j) s += (v[j].x * v[j].x + v[j].y * v[j].y) + (v[j].z * v[j].z + v[j].w * v[j].w);
    const float rs = 1.0f / sqrtf(wave_sum(s) * (1.f / DM) + EPS);
    if (UNNORM) {
#pragma unroll
        for (int j = 0; j < 2; ++j) { v4u w; w.x = pk2(v[2 * j].x, v[2 * j].y); w.y = pk2(v[2 * j].z, v[2 * j].w); w.z = pk2(v[2 * j + 1].x, v[2 * j + 1].y); w.w = pk2(v[2 * j + 1].z, v[2 * j + 1].w);
            *(GAS v4u*)(orow + 512 * j + 8 * lane) = w; }
        if (lane == 8) rs_out[0] = rs;
    }
#pragma unroll
    for (int j = 0; j < 4; ++j) v[j] = v[j] * rs;
    if (!UNNORM) {
#pragma unroll
        for (int j = 0; j < 2; ++j) { v4u w; w.x = pk2(v[2 * j].x, v[2 * j].y); w.y = pk2(v[2 * j].z, v[2 * j].w); w.z = pk2(v[2 * j + 1].x, v[2 * j + 1].y); w.w = pk2(v[2 * j + 1].z, v[2 * j + 1].w);
            *(GAS v4u*)(orow + 512 * j + 8 * lane) = w; }
    }
    if (UNNORM) {
        float mine = 0.f;
#pragma unroll
        for (int g = 0; g < 8; ++g) { float d = 0.f;
#pragma unroll
            for (int j = 0; j < 2; ++j) { const f32x4 w0 = wif[((g * 2 + j) * 2 + 0) * 64 + lane], w1 = wif[((g * 2 + j) * 2 + 1) * 64 + lane];
                d += (v[2 * j].x * w0.x + v[2 * j].y * w0.y) + (v[2 * j].z * w0.z + v[2 * j].w * w0.w) + (v[2 * j + 1].x * w1.x + v[2 * j + 1].y * w1.y) + (v[2 * j + 1].z * w1.z + v[2 * j + 1].w * w1.w); }
            d = wave_sum(d); if (lane == g) mine = d; }
        if (lane < 8) ifo[lane] = mine + (lane < 4 ? igb[lane] : fgb[lane - 4]);
    }
}
__device__ __forceinline__ void wif_to_lds(LAS f32x4* img, const float* wif, int tid) {
#pragma unroll
    for (int k = 0; k < 4; ++k) { const int pc = tid + NTHR * k, ln = pc & 63, h = (pc >> 6) & 1, j = (pc >> 7) & 1, g = pc >> 8;
        img[pc] = *(const GAS f32x4*)(wif + g * DM + 512 * j + 8 * ln + 4 * h); }
    __syncthreads();
}
template <int NB> __device__ __forceinline__ void rows_gates_bf16(const bf16* X, const LAS f32x4* wif, const float* igb, const float* fgb, float* IF, float* RS, int m0, int stride, int lane) {
    v4u xw[NB][2];
#pragma unroll
    for (int i = 0; i < NB; ++i)
#pragma unroll
        for (int j = 0; j < 2; ++j) xw[i][j] = *(const GAS v4u*)(X + (size_t)(m0 + i * stride) * DM + 512 * j + 8 * lane);
#pragma unroll
    for (int i = 0; i < NB; ++i) { const int m = m0 + i * stride; f32x4 v[4]; float s = 0.f;
#pragma unroll
        for (int j = 0; j < 2; ++j) { const v4u w = xw[i][j];
            v[2 * j] = (f32x4){bflo(w.x), bfhi(w.x), bflo(w.y), bfhi(w.y)}; v[2 * j + 1] = (f32x4){bflo(w.z), bfhi(w.z), bflo(w.w), bfhi(w.w)}; }
#pragma unroll
        for (int j = 0; j < 4; ++j) s += (v[j].x * v[j].x + v[j].y * v[j].y) + (v[j].z * v[j].z + v[j].w * v[j].w);
        const float rs = 1.0f / sqrtf(wave_sum(s) * (1.f / DM) + EPS);
        if (lane == 8) RS[m] = rs;
#pragma unroll
        for (int j = 0; j < 4; ++j) v[j] = v[j] * rs;
        float mine = 0.f;
#pragma unroll
        for (int g = 0; g < 8; ++g) { float d = 0.f;
#pragma unroll
            for (int j = 0; j < 2; ++j) { const f32x4 w0 = wif[((g * 2 + j) * 2 + 0) * 64 + lane], w1 = wif[((g * 2 + j) * 2 + 1) * 64 + lane];
                d += (v[2 * j].x * w0.x + v[2 * j].y * w0.y) + (v[2 * j].z * w0.z + v[2 * j].w * w0.w) + (v[2 * j + 1].x * w1.x + v[2 * j + 1].y * w1.y) + (v[2 * j + 1].z * w1.z + v[2 * j + 1].w * w1.w); }
            d = wave_sum(d); if (lane == g) mine = d; }
        if (lane < 8) IF[(size_t)m * 8 + lane] = mine + (lane < 4 ? igb[lane] : fgb[lane - 4]); }
}
template <int NB> __device__ __forceinline__ void rows_rs384(const bf16* base, float* rs, int m0, int stride, int lane) {
    unsigned w[NB][3];
#pragma unroll
    for (int i = 0; i < NB; ++i) { const GAS unsigned* p = (const GAS unsigned*)(base + (size_t)(m0 + i * stride) * 384) + lane * 3;
#pragma unroll
        for (int q = 0; q < 3; ++q) w[i][q] = p[q]; }
#pragma unroll
    for (int i = 0; i < NB; ++i) { float s = 0.f;
#pragma unroll
        for (int q = 0; q < 3; ++q) { const float x = bflo(w[i][q]), y = bfhi(w[i][q]); s += x * x + y * y; }
        s = wave_sum(s);
        if (lane == 0) rs[m0 + i * stride] = 1.0f / sqrtf(s * (1.f / 384) + EPS); }
}
template <int E> __device__ __forceinline__ void row_scale_bf16(bf16* row, int lane) {
    static_assert(E == 4 || E == 6, "E");
    GAS unsigned* p = (GAS unsigned*)row + lane * (E / 2); unsigned w[E / 2]; float s = 0.f;
#pragma unroll
    for (int i = 0; i < E / 2; ++i) { w[i] = p[i]; const float a = bflo(w[i]), b = bfhi(w[i]); s += a * a + b * b; }
    const float rs = 1.0f / sqrtf(wave_sum(s) * (1.f / (64 * E)) + EPS);
#pragma unroll
    for (int i = 0; i < E / 2; ++i) p[i] = pk2(bflo(w[i]) * rs, bfhi(w[i]) * rs);
}
template <int NB> __device__ __forceinline__ void head128_norm4(bf16* MK, const float* gain0, int idx0, int stride, int lane) {
    v4u w[NB];
#pragma unroll
    for (int i = 0; i < NB; ++i) w[i] = *((const GAS v4u*)(MK + (size_t)(idx0 + i * stride) * 512) + lane);
#pragma unroll
    for (int i = 0; i < NB; ++i) { float x[8]; float s = 0.f; const int idx = idx0 + i * stride;
#pragma unroll
        for (int e = 0; e < 4; ++e) { x[2 * e] = bflo(w[i][e]); x[2 * e + 1] = bfhi(w[i][e]); s += x[2 * e] * x[2 * e] + x[2 * e + 1] * x[2 * e + 1]; }
        s = sum16(s);
        const float rs = 1.0f / sqrtf(s * (1.f / 128) + EPS); const float* g = gain0 + (idx >> 12) * 128 + (lane & 15) * 8; v4u o;
#pragma unroll
        for (int e = 0; e < 4; ++e) o[e] = pk2(x[2 * e] * rs * g[2 * e], x[2 * e + 1] * rs * g[2 * e + 1]);
        *((GAS v4u*)(MK + (size_t)idx * 512) + lane) = o; }
}
template <int NB> __device__ __forceinline__ void gate_rows256(bf16* HT, const bf16* Gt, int idx0, int stride, int lane, bool live) {
    v4u w[NB], gg[NB];
#pragma unroll
    for (int i = 0; i < NB; ++i) { const size_t o = (size_t)(idx0 + i * stride) * 512 + lane * 8; w[i] = *(const GAS v4u*)(HT + o); gg[i] = *(const GAS v4u*)(Gt + o); }
#pragma unroll
    for (int i = 0; i < NB; ++i) { float x[8]; float s = 0.f;
#pragma unroll
        for (int e = 0; e < 4; ++e) { x[2 * e] = bflo(w[i][e]); x[2 * e + 1] = bfhi(w[i][e]); s += x[2 * e] * x[2 * e] + x[2 * e + 1] * x[2 * e + 1]; }
        s += __shfl_xor(s, 1); s += __shfl_xor(s, 2); s += __shfl_xor(s, 4); s += __shfl_xor(s, 8); s += __shfl_xor(s, 16);
        const float rs = 1.0f / sqrtf(s * (1.f / 256) + EPS); v4u o;
#pragma unroll
        for (int e = 0; e < 4; ++e) o[e] = pk2(x[2 * e] * rs * bflo(gg[i][e]), x[2 * e + 1] * rs * bfhi(gg[i][e]));
        if (live) *(GAS v4u*)(HT + (size_t)(idx0 + i * stride) * 512 + lane * 8) = o; }
}
__device__ __forceinline__ void rope_sincos(int pos, int i, float& sn, float& cs) {
    const float invf = exp2f(-(float)i * (13.287712379549449f / 32.0f));
    const float ang = (float)pos * invf;
    const double a = (double)ang; const double n = rint(a * 0.15915494309189535); const float r = (float)(a - n * 6.283185307179586);
    sn = sinf(r); cs = cosf(r);
}
template <int NB> __device__ __forceinline__ void rope_tokens(bf16* base, const bf16* KPE, const bf16* LAT, const float* gain, const float* rt, int t0, int stride, int lane, bool live) {
    const int hh = lane >> 3, sub = lane & 7;
    v4u n0[NB], n1[NB], rp[NB]; f32x4 sc[NB][4]; float ls[NB];
#pragma unroll
    for (int i = 0; i < NB; ++i) { const int t = t0 + i * stride; const bf16* ph = base + (size_t)t * 1536 + hh * 192;
        n0[i] = *(const GAS v4u*)(ph + sub * 16); n1[i] = *(const GAS v4u*)(ph + sub * 16 + 8);
        rp[i] = KPE ? *(const GAS v4u*)(KPE + (size_t)t * 64 + sub * 8) : *(const GAS v4u*)(ph + 128 + sub * 8);
        const GAS f32x4* scp = (const GAS f32x4*)(rt + (size_t)t * 64 + (sub & 3) * 16);
#pragma unroll
        for (int q = 0; q < 4; ++q) sc[i][q] = scp[q];
        ls[i] = 0.f;
        if (LAT) { const GAS unsigned* lp = (const GAS unsigned*)(LAT + (size_t)t * 384) + lane * 3;
#pragma unroll
            for (int q = 0; q < 3; ++q) { const unsigned lw = lp[q]; const float x = bflo(lw), y = bfhi(lw); ls[i] += x * x + y * y; } } }
    float gn[16], gr[8];
#pragma unroll
    for (int q = 0; q < 4; ++q) { const f32x4 g4 = *(const GAS f32x4*)(gain + sub * 16 + 4 * q); gn[4 * q] = g4[0]; gn[4 * q + 1] = g4[1]; gn[4 * q + 2] = g4[2]; gn[4 * q + 3] = g4[3]; }
#pragma unroll
    for (int q = 0; q < 2; ++q) { const f32x4 g4 = *(const GAS f32x4*)(gain + 128 + sub * 8 + 4 * q); gr[4 * q] = g4[0]; gr[4 * q + 1] = g4[1]; gr[4 * q + 2] = g4[2]; gr[4 * q + 3] = g4[3]; }
#pragma unroll
    for (int i = 0; i < NB; ++i) { const int t = t0 + i * stride; bf16* ph = base + (size_t)t * 1536 + hh * 192;
        float xn[16], xr[8]; float s = 0.f;
#pragma unroll
        for (int e = 0; e < 4; ++e) { xn[2 * e] = bflo(n0[i][e]); xn[2 * e + 1] = bfhi(n0[i][e]); xn[8 + 2 * e] = bflo(n1[i][e]); xn[8 + 2 * e + 1] = bfhi(n1[i][e]); xr[2 * e] = bflo(rp[i][e]); xr[2 * e + 1] = bfhi(rp[i][e]); }
        float rl = 1.f;
        if (LAT) rl = 1.0f / sqrtf(wave_sum(ls[i]) * (1.f / 384) + EPS);
#pragma unroll
        for (int e = 0; e < 16; ++e) { xn[e] *= rl; s += xn[e] * xn[e]; }
#pragma unroll
        for (int e = 0; e < 8; ++e) { xr[e] *= rl; s += xr[e] * xr[e]; }
        s = sum8(s);
        const float rs = 1.0f / sqrtf(s * (1.f / 192) + EPS);
        v4u o0, o1, o2;
#pragma unroll
        for (int e = 0; e < 4; ++e) { o0[e] = pk2(xn[2 * e] * rs * gn[2 * e], xn[2 * e + 1] * rs * gn[2 * e + 1]); o1[e] = pk2(xn[8 + 2 * e] * rs * gn[8 + 2 * e], xn[8 + 2 * e + 1] * rs * gn[8 + 2 * e + 1]); }
        float ro[8];
#pragma unroll
        for (int e = 0; e < 8; ++e) { const float own = xr[e] * rs * gr[e], oth = __shfl_xor(own, 4); const float sn = sc[i][e >> 1][(e & 1) * 2], cs = sc[i][e >> 1][(e & 1) * 2 + 1];
            ro[e] = (sub < 4) ? (own * cs - oth * sn) : (oth * sn + own * cs); }
#pragma unroll
        for (int e = 0; e < 4; ++e) o2[e] = pk2(ro[2 * e], ro[2 * e + 1]);
        if (live) { *(GAS v4u*)(ph + sub * 16) = o0; *(GAS v4u*)(ph + sub * 16 + 8) = o1; *(GAS v4u*)(ph + 128 + sub * 8) = o2; } }
}

__device__ __forceinline__ void conv_fixup(bf16* QKR, const bf16* HALO, const bf16* HALO2, const float* cw, const float* cb, int gid, bool live) {
    const int cg = gid & 255, chunk = gid >> 8, col = cg * 8;
    if (chunk >= T / 64) return;
    v4u raw[6];
#pragma unroll
    for (int i = 0; i < 3; ++i) { raw[i] = ((chunk & 31) != 0) ? *(const GAS v4u*)(HALO + ((size_t)(chunk - 1) * 3 + i) * 2048 + col) : (v4u){0u, 0u, 0u, 0u};
        raw[3 + i] = *(const GAS v4u*)(HALO2 + ((size_t)chunk * 3 + i) * 2048 + col); }
    float w[4][8], bb[8];
#pragma unroll
    for (int j = 0; j < 4; ++j) { const f32x4 a = *(const GAS f32x4*)(cw + j * 2048 + col), b = *(const GAS f32x4*)(cw + j * 2048 + col + 4);
        w[j][0] = a.x; w[j][1] = a.y; w[j][2] = a.z; w[j][3] = a.w; w[j][4] = b.x; w[j][5] = b.y; w[j][6] = b.z; w[j][7] = b.w; }
    { const f32x4 a = *(const GAS f32x4*)(cb + col), b = *(const GAS f32x4*)(cb + col + 4); bb[0] = a.x; bb[1] = a.y; bb[2] = a.z; bb[3] = a.w; bb[4] = b.x; bb[5] = b.y; bb[6] = b.z; bb[7] = b.w; }
    const float osc = (col < 1024) ? 0.0625f : 1.0f;
#pragma unroll
    for (int i = 0; i < 3; ++i) { float o[8];
#pragma unroll
        for (int e = 0; e < 8; ++e) { float acc = bb[e];
#pragma unroll
            for (int j = 0; j < 4; ++j) { const unsigned wd = raw[i + j][e >> 1]; const float xv = (e & 1) ? bfhi(wd) : bflo(wd); acc = fmaf(w[j][e], xv, acc); }
            o[e] = siluf_(acc) * osc; }
        v4u ov; ov.x = pk2(o[0], o[1]); ov.y = pk2(o[2], o[3]); ov.z = pk2(o[4], o[5]); ov.w = pk2(o[6], o[7]);
        if (live) *(GAS v4u*)(QKR + ((size_t)chunk * 64 + i) * 2048 + col) = ov; }
}

namespace pg8 {
__device__ __forceinline__ void st8(bf16_t* p, const f32x4 a, const f32x4 b) { u32x4 w; w.x = cvt_pk_bf16(a[0], a[1]); w.y = cvt_pk_bf16(a[2], a[3]); w.z = cvt_pk_bf16(b[0], b[1]); w.w = cvt_pk_bf16(b[2], b[3]); *(u32x4*)p = w; }
__device__ __forceinline__ f32x4 silu4(const f32x4 v) { f32x4 o; o[0] = siluf_(v[0]); o[1] = siluf_(v[1]); o[2] = siluf_(v[2]); o[3] = siluf_(v[3]); return o; }
__device__ __forceinline__ f32x4 ozgate4(const f32x4 o, const f32x4 z) { f32x4 r; r[0] = sigmoidf_(o[0]) * siluf_(z[0]); r[1] = sigmoidf_(o[1]) * siluf_(z[1]); r[2] = sigmoidf_(o[2]) * siluf_(z[2]); r[3] = sigmoidf_(o[3]) * siluf_(z[3]); return r; }

__device__ __forceinline__ u32x4 pack8(const f32x4 a, const f32x4 b) { u32x4 w; w.x = cvt_pk_bf16(a[0], a[1]); w.y = cvt_pk_bf16(a[2], a[3]); w.z = cvt_pk_bf16(b[0], b[1]); w.w = cvt_pk_bf16(b[2], b[3]); return w; }
__device__ __forceinline__ u32x4 swap8u(const u32x4 v) { u32x4 r;
#pragma unroll
    for (int i = 0; i < 4; ++i) r[i] = (unsigned)__builtin_amdgcn_update_dpp(0, (int)v[i], 0x128, 0xf, 0xf, false);
    return r; }
__device__ __forceinline__ void st8x2(bf16_t* p, int pitch, const u32x4 g0, const u32x4 g1, bool lo, u32x4& A, u32x4& B) {
    const u32x4 y = swap8u(lo ? g1 : g0); A = lo ? g0 : y; B = lo ? y : g1;
    *(u32x4*)p = A; *(u32x4*)(p + (size_t)8 * pitch) = B; }

struct EpiStore { static constexpr bool PERM = true, AFTER_DRAIN = false, KSCALE = false, SRC2 = false; bf16_t* O; int ldc; int live;
    __device__ __forceinline__ void operator()(const f32x4 (&acc)[2][2][4][2], const Unit& u, int ui, int wr, int wc, int fr, int fq) const {
        const bool lo = fr < 8; const int row0 = u.pm * BM + wr * 64 + (fr & 7), col0 = u.pn * BM + wc * 64 + 8 * fq + (lo ? 0 : 32);
#pragma unroll
        for (int ai = 0; ai < 2; ++ai)
#pragma unroll
            for (int m = 0; m < 4; ++m) { u32x4 A, B; if (live) st8x2(O + (size_t)(row0 + ai * HALF + m * 16) * ldc + col0, ldc, pack8(acc[ai][0][m][0], acc[ai][0][m][1]), pack8(acc[ai][1][m][0], acc[ai][1][m][1]), lo, A, B); }
    }
};
struct EpiMemKV { static constexpr bool PERM = true, AFTER_DRAIN = false, KSCALE = false, SRC2 = false; bf16_t* MK; bf16_t* MV;
    __device__ __forceinline__ void operator()(const f32x4 (&acc)[2][2][4][2], const Unit& u, int ui, int wr, int wc, int fr, int fq) const {
        const bool lo = fr < 8;
        const int l = u.pn >> 2, q = u.pn & 3; bf16_t* const mk_ = MK; const ptrdiff_t dmv_ = MV - mk_; bf16_t* base = mk_ + (q < 2 ? (ptrdiff_t)0 : dmv_) + (size_t)l * TM * 512 + (q & 1) * 256 + wc * 64 + 8 * fq + (lo ? 0 : 32);
        const int row0 = u.pm * BM + wr * 64 + (fr & 7);
#pragma unroll
        for (int ai = 0; ai < 2; ++ai)
#pragma unroll
            for (int m = 0; m < 4; ++m) { u32x4 A, B; st8x2(base + (size_t)(row0 + ai * HALF + m * 16) * 512, 512, pack8(acc[ai][0][m][0], acc[ai][0][m][1]), pack8(acc[ai][1][m][0], acc[ai][1][m][1]), lo, A, B); }
    }
};
struct EpiA { static constexpr bool PERM = true, AFTER_DRAIN = false, KSCALE = false, SRC2 = false; bf16_t *QKR, *HALO, *V, *G, *MQ; const PG8_LAS float* rsl; bf16_t* HALO2; const float* cw; const float* cb; PG8_LAS unsigned char* win;
    __device__ __forceinline__ void operator()(const f32x4 (&acc)[2][2][4][2], const Unit& u, int ui, int wr, int wc, int fr, int fq) const {
        const bool lo = fr < 8; const int pn = u.pn;
        const int rowb = u.pm * BM + wr * 64, cl = wc * 64 + 8 * fq + (lo ? 0 : 32);
        if (pn < 8) {
            asm volatile("" : "+v"(fr), "+v"(fq));
            const int f7 = fr & 7, bjq = (fr < 8) ? 0 : 1, colq = pn * 256 + wc * 64 + 8 * fq + bjq * 32;
            u32x4 gg[2][4][2];
#pragma unroll
            for (int ai = 0; ai < 2; ++ai)
#pragma unroll
                for (int m = 0; m < 4; ++m) { const float r_ = rsl[ui * 256 + wr * 64 + ai * HALF + m * 16 + fr];
                    gg[ai][m][0] = pack8(acc[ai][0][m][0] * r_, acc[ai][0][m][1] * r_); gg[ai][m][1] = pack8(acc[ai][1][m][0] * r_, acc[ai][1][m][1] * r_); }
            __builtin_amdgcn_sched_barrier(0);
            float w[4][8], bb[8];
#pragma unroll
            for (int j = 0; j < 4; ++j) { const f32x4 x = *(const f32x4*)(cw + j * 2048 + colq), y = *(const f32x4*)(cw + j * 2048 + colq + 4);
                w[j][0] = x[0]; w[j][1] = x[1]; w[j][2] = x[2]; w[j][3] = x[3]; w[j][4] = y[0]; w[j][5] = y[1]; w[j][6] = y[2]; w[j][7] = y[3]; }
            { const f32x4 x = *(const f32x4*)(cb + colq), y = *(const f32x4*)(cb + colq + 4); bb[0] = x[0]; bb[1] = x[1]; bb[2] = x[2]; bb[3] = x[3]; bb[4] = y[0]; bb[5] = y[1]; bb[6] = y[2]; bb[7] = y[3]; }
            const float osc = (pn < 4) ? 0.0625f : 1.0f;
            PG8_LAS unsigned char* wv = win + (wr * 4 + wc) * (19 * 128);
#pragma unroll
            for (int ai = 0; ai < 2; ++ai) { const int chunk = (rowb + ai * HALF) >> 6;
#pragma unroll
                for (int m = 0; m < 4; ++m) {
                    const u32x4 g0 = gg[ai][m][0], g1 = gg[ai][m][1];
                    int sw = (16 * m) % 19 + fr; sw -= (sw >= 19) ? 19 : 0;
                    *(PG8_LAS u32x4*)(wv + sw * 128 + ((fq ^ (sw & 7)) << 4)) = g0; *(PG8_LAS u32x4*)(wv + sw * 128 + (((4 + fq) ^ (sw & 7)) << 4)) = g1;
                    if (m == 3 && fr >= 13) { bf16_t* hp = HALO + ((size_t)chunk * 3 + (fr - 13)) * 2048 + pn * 256 + wc * 64 + 8 * fq; *(u32x4*)hp = g0; *(u32x4*)(hp + 32) = g1; }
                    if (m == 0 && fr < 3) { bf16_t* hp = HALO2 + ((size_t)chunk * 3 + fr) * 2048 + pn * 256 + wc * 64 + 8 * fq; *(u32x4*)hp = g0; *(u32x4*)(hp + 32) = g1; }
#pragma unroll
                    for (int hf = 0; hf < 2; ++hf) { const int rr = 16 * m + 8 * hf + f7;
                        u32x4 rw[4];
#pragma unroll
                        for (int j = 0; j < 4; ++j) { int s_ = ((16 * m + 8 * hf - j) % 19 + 19) % 19 + f7; s_ -= (s_ >= 19) ? 19 : 0;
                            rw[j] = *(const PG8_LAS u32x4*)(wv + s_ * 128 + (((bjq * 4 + fq) ^ (s_ & 7)) << 4)); }
                        float o[8];
#pragma unroll
                        for (int e = 0; e < 8; ++e) { float a_ = bb[e];
#pragma unroll
                            for (int j = 0; j < 4; ++j) { const unsigned wd = rw[j][e >> 1]; a_ = fmaf(w[3 - j][e], (e & 1) ? bfhi(wd) : bflo(wd), a_); }
                            o[e] = siluf_(a_) * osc; }
                        u32x4 ov; ov.x = cvt_pk_bf16(o[0], o[1]); ov.y = cvt_pk_bf16(o[2], o[3]); ov.z = cvt_pk_bf16(o[4], o[5]); ov.w = cvt_pk_bf16(o[6], o[7]);
                        if (!(m == 0 && hf == 0 && f7 < 3)) *(u32x4*)(QKR + (size_t)(rowb + ai * HALF + rr) * 2048 + colq) = ov;
                        __builtin_amdgcn_sched_barrier(0); }
                } }
            return;
        }
#pragma unroll
        for (int ai = 0; ai < 2; ++ai)
#pragma unroll
            for (int m = 0; m < 4; ++m) { const int rg = rowb + ai * HALF + m * 16; const size_t row = (size_t)(rg + (fr & 7)); u32x4 A, B;
                const float r_ = rsl[ui * 256 + wr * 64 + ai * HALF + m * 16 + fr];
                const f32x4 a00 = acc[ai][0][m][0] * r_, a01 = acc[ai][0][m][1] * r_, a10 = acc[ai][1][m][0] * r_, a11 = acc[ai][1][m][1] * r_;
                if (pn < 12) {
                    st8x2(V + row * 1024 + (pn - 8) * 256 + cl, 1024, pack8(a00, a01), pack8(a10, a11), lo, A, B);
                } else if (pn < 20) {
                    st8(G + (size_t)(rg + fr) * 1024 + (pn - 12) * 128 + wc * 32 + 8 * fq, ozgate4(a00, a10), ozgate4(a01, a11));
                } else if (pn < 22) {
                    st8x2(MQ + row * 1024 + (pn - 20) * 256 + cl, 1024, pack8(a00, a01), pack8(a10, a11), lo, A, B);
                } else {
                    st8x2(MQ + row * 1024 + 512 + (pn - 22) * 256 + cl, 1024, pack8(silu4(a00), silu4(a01)), pack8(silu4(a10), silu4(a11)), lo, A, B);
                }
            }
    }
};
struct EpiB { static constexpr bool PERM = true, AFTER_DRAIN = false, KSCALE = false, SRC2 = false; bf16_t *ZB, *MQ, *QLAT, *CKV, *KPE; const PG8_LAS float* rsl;
    __device__ __forceinline__ void operator()(const f32x4 (&acc)[2][2][4][2], const Unit& u, int ui, int wr, int wc, int fr, int fq) const {
        const bool lo = fr < 8; const int rowb = u.pm * BM + wr * 64 + (fr & 7);
        const int cb = u.pn * 256 + wc * 64;
        const int co = 8 * fq + (lo ? 0 : 32);
        bf16_t* dst = nullptr; int pitch = 0; bool act = false;
        if (cb < 1024) { dst = ZB + cb + co; pitch = 1024; act = true; }
        else if (cb < 1536) { dst = MQ + (cb - 1024) + co; pitch = 1024; }
        else if (cb < 2048) { dst = MQ + 512 + (cb - 1536) + co; pitch = 1024; act = true; }
        else if (cb < 2432) { dst = QLAT + (cb - 2048) + co; pitch = 384; }
        else if (CKV && cb < 2688) { dst = CKV + (cb - 2432) + co; pitch = 256; }
        else if (CKV && cb < 2752) { dst = KPE + (cb - 2688) + co; pitch = 64; }
        if (dst) {
#pragma unroll
            for (int ai = 0; ai < 2; ++ai)
#pragma unroll
                for (int m = 0; m < 4; ++m) { const size_t row = (size_t)(rowb + ai * HALF + m * 16); u32x4 A, B;
                    const float r_ = rsl[ui * 256 + wr * 64 + ai * HALF + m * 16 + fr];
                    const f32x4 a00 = acc[ai][0][m][0] * r_, a01 = acc[ai][0][m][1] * r_, a10 = acc[ai][1][m][0] * r_, a11 = acc[ai][1][m][1] * r_;
                    const u32x4 g0 = act ? pack8(silu4(a00), silu4(a01)) : pack8(a00, a01);
                    const u32x4 g1 = act ? pack8(silu4(a10), silu4(a11)) : pack8(a10, a11);
                    st8x2(dst + row * pitch, pitch, g0, g1, lo, A, B); }
        }
    }
};
struct EpiKvb { static constexpr bool PERM = true, AFTER_DRAIN = false, KSCALE = false, SRC2 = false; bf16_t *KSH, *VSH; const PG8_LAS float* rsl;
    __device__ __forceinline__ void operator()(const f32x4 (&acc)[2][2][4][2], const Unit& u, int ui, int wr, int wc, int fr, int fq) const {
        const bool lo = fr < 8; const int rowb = u.pm * BM + wr * 64 + (fr & 7), h = u.pn, co = (wc & 1) * 64 + 8 * fq + (lo ? 0 : 32);
        bf16_t* dst = (wc < 2) ? KSH + h * 192 + co : VSH + h * 128 + co; const int pitch = (wc < 2) ? 1536 : 1024;
#pragma unroll
        for (int ai = 0; ai < 2; ++ai)
#pragma unroll
            for (int m = 0; m < 4; ++m) { u32x4 A, B; const float r_ = rsl[ui * 256 + wr * 64 + ai * HALF + m * 16 + fr];
                st8x2(dst + (size_t)(rowb + ai * HALF + m * 16) * pitch, pitch, pack8(acc[ai][0][m][0] * r_, acc[ai][0][m][1] * r_), pack8(acc[ai][1][m][0] * r_, acc[ai][1][m][1] * r_), lo, A, B); }
    }
};
__device__ __forceinline__ f32x4 swap8(const f32x4 v) { f32x4 r;
#pragma unroll
    for (int i = 0; i < 4; ++i) r[i] = __int_as_float(__builtin_amdgcn_update_dpp(0, __float_as_int(v[i]), 0x128, 0xf, 0xf, false));
    return r; }
__device__ __forceinline__ float swap8f(const float v) { return __int_as_float(__builtin_amdgcn_update_dpp(0, __float_as_int(v), 0x128, 0xf, 0xf, false)); }
struct EpiResB { static constexpr bool PERM = true, AFTER_DRAIN = false, KSCALE = false, SRC2 = true; bf16_t* X; float* SSQ; int live;
    __device__ __forceinline__ void operator()(const f32x4 (&acc)[2][2][4][2], const Unit& u, int ui, int wr, int wc, int fr, int fq) const {
        const bool lo = fr < 8;
        const int row0 = u.pm * BM + wr * 64 + (fr & 7), col0 = u.pn * BM + wc * 64 + 8 * fq + (lo ? 0 : 32);
        float* sq = SSQ + (size_t)(row0 + (lo ? 0 : 8)) * 16 + u.pn * 4 + wc;
#pragma unroll
        for (int ai = 0; ai < 2; ++ai)
#pragma unroll
            for (int m = 0; m < 4; ++m) { bf16_t* p = X + (size_t)(row0 + ai * HALF + m * 16) * DM + col0;
                const f32x4 y0 = swap8(lo ? acc[ai][1][m][0] : acc[ai][0][m][0]), y1 = swap8(lo ? acc[ai][1][m][1] : acc[ai][0][m][1]);
                const f32x4 A0 = lo ? acc[ai][0][m][0] : y0, A1 = lo ? acc[ai][0][m][1] : y1, B0 = lo ? y0 : acc[ai][1][m][0], B1 = lo ? y1 : acc[ai][1][m][1];
                const u32x4 xa = *(const u32x4*)p, xb = *(const u32x4*)(p + (size_t)8 * DM);
                const f32x4 na0 = {bflo(xa.x) + A0[0], bfhi(xa.x) + A0[1], bflo(xa.y) + A0[2], bfhi(xa.y) + A0[3]}, na1 = {bflo(xa.z) + A1[0], bfhi(xa.z) + A1[1], bflo(xa.w) + A1[2], bfhi(xa.w) + A1[3]};
                const f32x4 nb0 = {bflo(xb.x) + B0[0], bfhi(xb.x) + B0[1], bflo(xb.y) + B0[2], bfhi(xb.y) + B0[3]}, nb1 = {bflo(xb.z) + B1[0], bfhi(xb.z) + B1[1], bflo(xb.w) + B1[2], bfhi(xb.w) + B1[3]};
                if (live) { *(u32x4*)p = pack8(na0, na1); *(u32x4*)(p + (size_t)8 * DM) = pack8(nb0, nb1); }
                float sA = ((na0[0] * na0[0] + na0[1] * na0[1]) + (na0[2] * na0[2] + na0[3] * na0[3])) + ((na1[0] * na1[0] + na1[1] * na1[1]) + (na1[2] * na1[2] + na1[3] * na1[3]));
                float sB = ((nb0[0] * nb0[0] + nb0[1] * nb0[1]) + (nb0[2] * nb0[2] + nb0[3] * nb0[3])) + ((nb1[0] * nb1[0] + nb1[1] * nb1[1]) + (nb1[2] * nb1[2] + nb1[3] * nb1[3]));
                sA += swap8f(sA); sB += swap8f(sB);
                { auto r_ = __builtin_amdgcn_permlane16_swap(__float_as_uint(sA), __float_as_uint(sA), false, false); sA = __uint_as_float(r_[0]) + __uint_as_float(r_[1]); }
                { auto r_ = __builtin_amdgcn_permlane16_swap(__float_as_uint(sB), __float_as_uint(sB), false, false); sB = __uint_as_float(r_[0]) + __uint_as_float(r_[1]); }
                { auto r_ = __builtin_amdgcn_permlane32_swap(__float_as_uint(sA), __float_as_uint(sA), false, false); sA = __uint_as_float(r_[0]) + __uint_as_float(r_[1]); }
                { auto r_ = __builtin_amdgcn_permlane32_swap(__float_as_uint(sB), __float_as_uint(sB), false, false); sB = __uint_as_float(r_[0]) + __uint_as_float(r_[1]); }
                if (fq == 0 && live) sq[(size_t)(ai * HALF + m * 16) * 16] = lo ? sA : sB; }
    }
};
struct EpiResBA : EpiResB { static constexpr bool KSCALE = true; const PG8_LAS float* ktab;
    __device__ __forceinline__ void kscale(f32x4 (&acc)[2][2][4][2], int ui, int sg, int wr, int fr) const {
        float f_[2][4];
#pragma unroll
        for (int ai = 0; ai < 2; ++ai)
#pragma unroll
            for (int m = 0; m < 4; ++m) f_[ai][m] = ktab[(ui * 256 + wr * 64 + ai * HALF + m * 16 + fr) * 4 + sg];
        __builtin_amdgcn_sched_barrier(0);
#pragma unroll
        for (int ai = 0; ai < 2; ++ai)
#pragma unroll
            for (int m = 0; m < 4; ++m)
#pragma unroll
                for (int bj = 0; bj < 2; ++bj)
#pragma unroll
                    for (int n_ = 0; n_ < 2; ++n_) acc[ai][bj][m][n_] = acc[ai][bj][m][n_] * f_[ai][m];
    }
};
struct EpiResF { static constexpr bool PERM = false, AFTER_DRAIN = false, KSCALE = false, SRC2 = true; const bf16_t* X; float* out; int live;
    __device__ __forceinline__ void operator()(const f32x4 (&acc)[2][2][4][2], const Unit& u, int ui, int wr, int wc, int fr, int fq) const {
        const bool lo = fr < 8;
        const int row0 = u.pm * BM + wr * 64 + (fr & 7), col0 = u.pn * BM + wc * 32 + 4 * fq + (lo ? 0 : 16);
#pragma unroll
        for (int ai = 0; ai < 2; ++ai)
#pragma unroll
            for (int m = 0; m < 4; ++m) { const size_t off = (size_t)(row0 + ai * HALF + m * 16) * DM + col0;
#pragma unroll
                for (int bj = 0; bj < 2; ++bj) { const f32x4 v0 = acc[ai][bj][m][0], v1 = acc[ai][bj][m][1];
                    const f32x4 y = swap8(lo ? v1 : v0);
                    const f32x4 a = lo ? v0 : y, b = lo ? y : v1;
                    const u32x2 xa = *(const u32x2*)(X + off + bj * HALF), xb = *(const u32x2*)(X + off + bj * HALF + 8 * DM);
                    const f32x4 oa = {bflo(xa.x) + a[0], bfhi(xa.x) + a[1], bflo(xa.y) + a[2], bfhi(xa.y) + a[3]}, ob = {bflo(xb.x) + b[0], bfhi(xb.x) + b[1], bflo(xb.y) + b[2], bfhi(xb.y) + b[3]};
                    if (live) { *(f32x4*)(out + off + bj * HALF) = oa; *(f32x4*)(out + off + bj * HALF + 8 * DM) = ob; } } }
    }
};
}

namespace ml {
constexpr int QP = 528, PP = 144;
constexpr int O_Q = 0, O_K = 64 * QP, O_CB = 2 * 64 * QP, O_P = 3 * 64 * QP, O_V = O_P + 64 * PP, O_H = O_V + 64 * PP, O_F = O_H + 64 * PP;
constexpr int F_U = 0, F_MT = 64, F_GT = 128, F_CL = 192, F_WA = 256, F_DEN = 320, F_QN = 384, F_N = 448, F_MISC = 704, F_NP = 712, F_WORDS = 712 + 1024;
constexpr int LDS_USED = O_F + F_WORDS * 4;
static_assert(LDS_USED <= MISC_OFF, "mLSTM LDS map");
__device__ __forceinline__ float logsigmoid_(float x) { return (x >= 0.f) ? -log1pf(expf(-x)) : x - log1pf(expf(x)); }
typedef short v4i16_t __attribute__((ext_vector_type(4)));
__device__ __forceinline__ s16x4 tr4(LAS unsigned char* p) { return __builtin_bit_cast(s16x4, __builtin_amdgcn_ds_read_tr16_b64_v4i16((LAS v4i16_t*)p)); }

__device__ __forceinline__ void gate_scan_item(const float* IFb, float* GATE, int item, int lane) {
    const int c = item & 31, h = (item >> 5) & 3, b = item >> 7; const size_t row = (size_t)b * SEQ + c * 64 + lane;
    const float ip = IFb[row * 8 + h], fp = IFb[row * 8 + 4 + h];
    float bc = logsigmoid_(fp);
#pragma unroll
    for (int o = 1; o < 64; o <<= 1) { const float t = __shfl_up(bc, o); if (lane >= o) bc += t; }
    const float u = ip - bc; float mx = u;
#pragma unroll
    for (int o = 1; o < 64; o <<= 1) { const float t = __shfl_up(mx, o); if (lane >= o) mx = fmaxf(mx, t); }
    float* g = GATE + (size_t)item * 192; g[lane] = u; g[64 + lane] = mx; g[128 + lane] = bc;
}

__device__ __forceinline__ void mlstm_item(LAS unsigned char* lds, const bf16* QK, bf16* VH, const bf16* Gt, float* SSH, const float* GATE, int b, int h, int sl, const int tid_in, const bool live) {
    int tid = tid_in; asm volatile("" : "+v"(tid));
    const int lane = tid & 63, w = __builtin_amdgcn_readfirstlane(tid >> 6), l15 = lane & 15, g = lane >> 4;
    LAS float* F = (LAS float*)(lds + O_F);
    const size_t row0 = (size_t)b * SEQ;
    const bf16* Qg = QK + row0 * 2048 + h * 256; const bf16* Kg = Qg + 1024;
    bf16* Vg = VH + row0 * 1024 + h * 256 + sl * 64; const bf16* Gg = Gt + row0 * 1024 + h * 256 + sl * 64; float* Sg = SSH + row0 * 16 + h * 4 + sl;
    const float* Gsc = GATE + (size_t)(b * 4 + h) * 32 * 192;
    const int qrow = tid >> 5, qch = tid & 31, vrow = tid >> 3, vch = tid & 7;
    v4u sq[4], sk[4], sv, sgt = (v4u){0u, 0u, 0u, 0u}; float sg_u = 0.f, sg_mx = 0.f, sg_b = 0.f;
#define ML_HSTORE(cc) do { const v4u hv_ = *(const LAS v4u*)(lds + O_H + vrow * PP + vch * 16); v4u o_; float s_ = 0.f; \
        _Pragma("unroll") for (int e_ = 0; e_ < 4; ++e_) { const float a_ = bflo(hv_[e_]), b_ = bfhi(hv_[e_]); s_ += a_ * a_ + b_ * b_; o_[e_] = pk2(a_ * bflo(sgt[e_]), b_ * bfhi(sgt[e_])); } \
        s_ += __int_as_float(__builtin_amdgcn_update_dpp(0, __float_as_int(s_), 0xB1, 0xf, 0xf, false)); s_ += __int_as_float(__builtin_amdgcn_update_dpp(0, __float_as_int(s_), 0x4E, 0xf, 0xf, false)); \
        s_ += __int_as_float(__builtin_amdgcn_update_dpp(0, __float_as_int(s_), 0x141, 0xf, 0xf, false));     \
        if (live) { *(GAS v4u*)(Vg + ((size_t)(cc) * 64 + vrow) * 1024 + vch * 8) = o_; if (vch == 0) Sg[((size_t)(cc) * 64 + vrow) * 16] = s_; } } while (0)
#define ML_LOAD(c) do { const size_t r_ = (size_t)(c) * 64; \
        _Pragma("unroll") for (int i_ = 0; i_ < 4; ++i_) { sq[i_] = *(const GAS v4u*)(Qg + (r_ + qrow + 16 * i_) * 2048 + qch * 8); sk[i_] = *(const GAS v4u*)(Kg + (r_ + qrow + 16 * i_) * 2048 + qch * 8); } \
        sv = *(const GAS v4u*)(Vg + (r_ + vrow) * 1024 + vch * 8); \
        if (w == 0) { const float* gp_ = Gsc + (size_t)(c) * 192; sg_u = gp_[lane]; sg_mx = gp_[64 + lane]; sg_b = gp_[128 + lane]; } } while (0)
    f32x4 Cst[2][4];
#pragma unroll
    for (int a = 0; a < 2; ++a)
#pragma unroll
        for (int v = 0; v < 4; ++v) Cst[a][v] = (f32x4){0.f, 0.f, 0.f, 0.f};
    float nreg = 0.f, m_run = 0.f;
    __syncthreads();
    for (int i = tid; i < 64 * QP / 4; i += NTHR) ((LAS unsigned*)(lds + O_CB))[i] = 0u;
    if (tid < 256) F[F_N + tid] = 0.f;
    ML_LOAD(0);
    for (int c = 0; c < SEQ / 64; ++c) {
#pragma unroll
        for (int i = 0; i < 4; ++i) { *(LAS v4u*)(lds + O_Q + (qrow + 16 * i) * QP + qch * 16) = sq[i]; *(LAS v4u*)(lds + O_K + (qrow + 16 * i) * QP + qch * 16) = sk[i]; }
        *(LAS v4u*)(lds + O_V + vrow * PP + vch * 16) = sv;
        if (w == 0) {
            const float Mt = fmaxf(m_run, sg_mx), Ml = __uint_as_float(__builtin_amdgcn_readlane(__float_as_uint(Mt), 63)), bl = __uint_as_float(__builtin_amdgcn_readlane(__float_as_uint(sg_b), 63));
            F[F_U + lane] = sg_u; F[F_MT + lane] = Mt; F[F_GT + lane] = __expf(m_run - Mt); F[F_CL + lane] = __expf(-(sg_b + Mt)); F[F_WA + lane] = __expf(sg_u - Ml); F[F_DEN + lane] = 0.f;
            if (lane == 0) { F[F_MISC + 0] = __expf(m_run - Ml); F[F_MISC + 1] = bl + Ml; }
        }
        __syncthreads();
        if (c + 1 < SEQ / 64) ML_LOAD(c + 1);
        {
          const int tr = tid >> 3, part = tid & 7; float s = 0.f;
#pragma unroll
          for (int i = 0; i < 4; ++i) { const v4u qv = *(const LAS v4u*)(lds + O_Q + tr * QP + (part * 32 + i * 8) * 2); const LAS float* nv = F + F_N + part * 32 + i * 8;
#pragma unroll
              for (int e = 0; e < 4; ++e) { s = fmaf(bflo(qv[e]), nv[2 * e], s); s = fmaf(bfhi(qv[e]), nv[2 * e + 1], s); } }
          s = sum8(s);
          if (part == 0) F[F_QN + tr] = s; }
        {
          const int dp = tid & 127, sq_ = tid >> 7; float s0 = 0.f, s1 = 0.f;
#pragma unroll
          for (int j = 0; j < 16; ++j) { const int s = 16 * sq_ + j; const unsigned kw = *(const LAS unsigned*)(lds + O_K + s * QP + dp * 4); const float wa = F[F_WA + s]; s0 = fmaf(wa, bflo(kw), s0); s1 = fmaf(wa, bfhi(kw), s1); }
          F[F_NP + sq_ * 256 + 2 * dp] = s0; F[F_NP + sq_ * 256 + 2 * dp + 1] = s1; }
        {
          const int ti = w & 3, sp = w >> 2; const int tcol = 16 * ti + l15; const float Mt_t = F[F_MT + tcol]; float rs_part = 0.f;
#pragma unroll
          for (int q = 0; q < 2; ++q) { const int si = 2 * sp + q; v2u pw = (v2u){0u, 0u};
              if (si <= ti) {
                  f32x4 acc = (f32x4){0.f, 0.f, 0.f, 0.f};
                  bf16x8 af[8], bfr[8];
#define ST_LOAD(kk_) do { af[kk_] = *(const LAS bf16x8*)(lds + O_K + (16 * si + l15) * QP + (32 * (kk_) + 8 * g) * 2); bfr[kk_] = *(const LAS bf16x8*)(lds + O_Q + tcol * QP + (32 * (kk_) + 8 * g) * 2); } while (0)
                  ST_LOAD(0); ST_LOAD(1); ST_LOAD(2); __builtin_amdgcn_sched_barrier(0);
#pragma unroll
                  for (int kk = 0; kk < 8; ++kk) { if (kk + 3 < 8) ST_LOAD(kk + 3); __builtin_amdgcn_sched_barrier(0);
                      acc = __builtin_amdgcn_mfma_f32_16x16x32_bf16(af[kk], bfr[kk], acc, 0, 0, 0); __builtin_amdgcn_sched_barrier(0); }
#undef ST_LOAD
                  const f32x4 uu = *(const LAS f32x4*)(F + F_U + 16 * si + 4 * g);
                  float p[4];
#pragma unroll
                  for (int r = 0; r < 4; ++r) { const int s = 16 * si + 4 * g + r; const float dd = __expf(uu[r] - Mt_t); p[r] = (s <= tcol) ? acc[r] * dd : 0.f; rs_part += p[r]; }
                  pw.x = pk2(p[0], p[1]); pw.y = pk2(p[2], p[3]);
              }
              *(LAS v2u*)(lds + O_P + tcol * PP + (16 * si + 4 * g) * 2) = pw; }
          rs_part = addx32(addx16(rs_part));
          if (g == 0) __hip_atomic_fetch_add(F + F_DEN + tcol, rs_part, __ATOMIC_RELAXED, __HIP_MEMORY_SCOPE_WORKGROUP); }
        if (c > 0) ML_HSTORE(c - 1);
        sgt = *(const GAS v4u*)(Gg + ((size_t)c * 64 + vrow) * 1024 + vch * 8);
        __syncthreads();
        const int trow = (l15 >> 2), tcol4 = 4 * (l15 & 3);
        bf16x8 vfr[4][2];
#pragma unroll
        for (int vi = 0; vi < 4; ++vi)
#pragma unroll
            for (int kk = 0; kk < 2; ++kk) { const s16x4 lo = tr4(lds + O_V + (32 * kk + 8 * g + trow) * PP + (16 * vi + tcol4) * 2), hi = tr4(lds + O_V + (32 * kk + 8 * g + 4 + trow) * PP + (16 * vi + tcol4) * 2);
                vfr[vi][kk] = (bf16x8){lo[0], lo[1], lo[2], lo[3], hi[0], hi[1], hi[2], hi[3]}; }
        { const int vi = w & 3, tp = w >> 2; const int vcol = 16 * vi + l15;
          bf16x8 cf[8];
#pragma unroll
          for (int kk = 0; kk < 8; ++kk) cf[kk] = *(const LAS bf16x8*)(lds + O_CB + vcol * QP + (32 * kk + 8 * g) * 2);
          const bf16x8 vf0 = (vi == 0) ? vfr[0][0] : (vi == 1) ? vfr[1][0] : (vi == 2) ? vfr[2][0] : vfr[3][0];
          const bf16x8 vf1 = (vi == 0) ? vfr[0][1] : (vi == 1) ? vfr[1][1] : (vi == 2) ? vfr[2][1] : vfr[3][1];
#pragma unroll
          for (int q = 0; q < 2; ++q) { const int ti = 2 * tp + q; f32x4 a1 = (f32x4){0.f, 0.f, 0.f, 0.f}, a2 = (f32x4){0.f, 0.f, 0.f, 0.f};
              { const bf16x8 pf0 = *(const LAS bf16x8*)(lds + O_P + (16 * ti + l15) * PP + (8 * g) * 2), pf1 = *(const LAS bf16x8*)(lds + O_P + (16 * ti + l15) * PP + (32 + 8 * g) * 2);
                a1 = __builtin_amdgcn_mfma_f32_16x16x32_bf16(pf0, vf0, a1, 0, 0, 0); a1 = __builtin_amdgcn_mfma_f32_16x16x32_bf16(pf1, vf1, a1, 0, 0, 0); }
              { bf16x8 qf[8];
#define NQ_LOAD(kk_) qf[kk_] = *(const LAS bf16x8*)(lds + O_Q + (16 * ti + l15) * QP + (32 * (kk_) + 8 * g) * 2)
                NQ_LOAD(0); NQ_LOAD(1); NQ_LOAD(2); NQ_LOAD(3); __builtin_amdgcn_sched_barrier(0);
#pragma unroll
                for (int kk = 0; kk < 8; ++kk) { if (kk + 4 < 8) NQ_LOAD(kk + 4); __builtin_amdgcn_sched_barrier(0); a2 = __builtin_amdgcn_mfma_f32_16x16x32_bf16(qf[kk], cf[kk], a2, 0, 0, 0); __builtin_amdgcn_sched_barrier(0); }
#undef NQ_LOAD
              }
              const f32x4 gt4 = *(const LAS f32x4*)(F + F_GT + 16 * ti + 4 * g), dn4 = *(const LAS f32x4*)(F + F_DEN + 16 * ti + 4 * g), qn4 = *(const LAS f32x4*)(F + F_QN + 16 * ti + 4 * g), cl4 = *(const LAS f32x4*)(F + F_CL + 16 * ti + 4 * g);
#pragma unroll
              for (int r = 0; r < 4; ++r) { const int t = 16 * ti + 4 * g + r; const float den = dn4[r] + gt4[r] * qn4[r];
                  const float hv = (a1[r] + gt4[r] * a2[r]) * __builtin_amdgcn_rcpf(fmaxf(fabsf(den), cl4[r]));
                  *(LAS bf16*)(lds + O_H + t * PP + vcol * 2) = (bf16)(pk2(hv, hv) & 0xffffu); } } }
        const float gs = F[F_MISC + 0], m_new = F[F_MISC + 1];
        {
          f32x4 wa4[2][2];
#pragma unroll
          for (int kk = 0; kk < 2; ++kk) { wa4[kk][0] = *(const LAS f32x4*)(F + F_WA + 32 * kk + 8 * g); wa4[kk][1] = *(const LAS f32x4*)(F + F_WA + 32 * kk + 8 * g + 4); }
#pragma unroll
          for (int a = 0; a < 2; ++a) { const int d0 = 16 * (2 * w + a);
              bf16x8 kf[2];
#pragma unroll
              for (int kk = 0; kk < 2; ++kk) { const s16x4 lo = tr4(lds + O_K + (32 * kk + 8 * g + trow) * QP + (d0 + tcol4) * 2), hi = tr4(lds + O_K + (32 * kk + 8 * g + 4 + trow) * QP + (d0 + tcol4) * 2);
                  v4u pk; pk.x = pk2(bf2f((bf16)lo[0]) * wa4[kk][0][0], bf2f((bf16)lo[1]) * wa4[kk][0][1]); pk.y = pk2(bf2f((bf16)lo[2]) * wa4[kk][0][2], bf2f((bf16)lo[3]) * wa4[kk][0][3]);
                  pk.z = pk2(bf2f((bf16)hi[0]) * wa4[kk][1][0], bf2f((bf16)hi[1]) * wa4[kk][1][1]); pk.w = pk2(bf2f((bf16)hi[2]) * wa4[kk][1][2], bf2f((bf16)hi[3]) * wa4[kk][1][3]);
                  kf[kk] = *reinterpret_cast<bf16x8*>(&pk); }
#pragma unroll
              for (int vi = 0; vi < 4; ++vi) { Cst[a][vi] = Cst[a][vi] * gs;
#pragma unroll
                  for (int kk = 0; kk < 2; ++kk) Cst[a][vi] = __builtin_amdgcn_mfma_f32_16x16x32_bf16(kf[kk], vfr[vi][kk], Cst[a][vi], 0, 0, 0); } } }
        m_run = m_new;
        __syncthreads();
#pragma unroll
        for (int a = 0; a < 2; ++a)
#pragma unroll
            for (int vi = 0; vi < 4; ++vi) { v2u o; o.x = pk2(Cst[a][vi][0], Cst[a][vi][1]); o.y = pk2(Cst[a][vi][2], Cst[a][vi][3]);
                *(LAS v2u*)(lds + O_CB + (16 * vi + l15) * QP + (16 * (2 * w + a) + 4 * g) * 2) = o; }
        if (tid < 256) { nreg = gs * nreg + ((F[F_NP + tid] + F[F_NP + 256 + tid]) + (F[F_NP + 512 + tid] + F[F_NP + 768 + tid])); F[F_N + tid] = nreg; }
    }
    __syncthreads();
    ML_HSTORE(SEQ / 64 - 1);
#undef ML_LOAD
#undef ML_HSTORE
}
}

namespace at {
constexpr int NW = 8, QBLK = 32, KVBLK = 64, DV = 128;
#define SBAR() __builtin_amdgcn_sched_barrier(0)
__device__ __forceinline__ int crow(int r, int hi) { return (r & 3) + 8 * (r >> 2) + 4 * hi; }
template <int DQ> __device__ __forceinline__ int kswz(int row, int colB) { return DQ == 128 ? row * 256 + (colB ^ ((row & 7) << 4)) : row * 384 + (colB ^ (((row >> 1) & 7) << 4)); }
__device__ __forceinline__ int v_st(int k, int c) { const int kk = (k & ~0xC) | ((k & 4) << 1) | ((k & 8) >> 1); return ((kk >> 3) * 4 + (c >> 5)) * 512 + ((kk & 7) * 32 + (c & 31)) * 2; }
__device__ __forceinline__ int v_rd_base(int lane) { return ((lane & 3) << 3) | (((lane >> 2) & 3) << 6) | (((lane >> 4) & 1) << 5) | (((lane >> 5) & 1) << 8); }
constexpr int v_rd_off(int d0, int ks, int half) { return d0 * 512 + ks * 4096 + half * 2048; }
template <int OFF> __device__ __forceinline__ s16x4 tr_read(int vb) { s16x4 r; asm volatile("ds_read_b64_tr_b16 %0, %1 offset:%2" : "=&v"(r) : "v"(vb), "i"(OFF) : "memory"); return r; }
struct VF { s16x4 l0, h0, l1, h1, l2, h2, l3, h3; };
template <int D0> __device__ __forceinline__ void v_issue(VF& f, int vb) {
    f.l0 = tr_read<v_rd_off(D0, 0, 0)>(vb); f.h0 = tr_read<v_rd_off(D0, 0, 1)>(vb); f.l1 = tr_read<v_rd_off(D0, 1, 0)>(vb); f.h1 = tr_read<v_rd_off(D0, 1, 1)>(vb);
    f.l2 = tr_read<v_rd_off(D0, 2, 0)>(vb); f.h2 = tr_read<v_rd_off(D0, 2, 1)>(vb); f.l3 = tr_read<v_rd_off(D0, 3, 0)>(vb); f.h3 = tr_read<v_rd_off(D0, 3, 1)>(vb);
}
__device__ __forceinline__ void v_mma(f32x16& od, const VF& f, bf16x8 pa0, bf16x8 pa1, bf16x8 pa2, bf16x8 pa3) {
#define PK(L, H) (bf16x8){L[0], L[1], L[2], L[3], H[0], H[1], H[2], H[3]}
    od = __builtin_amdgcn_mfma_f32_32x32x16_bf16(pa0, PK(f.l0, f.h0), od, 0, 0, 0);
    od = __builtin_amdgcn_mfma_f32_32x32x16_bf16(pa1, PK(f.l1, f.h1), od, 0, 0, 0);
    od = __builtin_amdgcn_mfma_f32_32x32x16_bf16(pa2, PK(f.l2, f.h2), od, 0, 0, 0);
    od = __builtin_amdgcn_mfma_f32_32x32x16_bf16(pa3, PK(f.l3, f.h3), od, 0, 0, 0);
#undef PK
}
__device__ __forceinline__ void pv_d0(f32x16* o, int vb, bf16x8 pa0, bf16x8 pa1, bf16x8 pa2, bf16x8 pa3) {
    VF fa, fb;
    v_issue<0>(fa, vb); SBAR();
    v_issue<1>(fb, vb); asm volatile("s_waitcnt lgkmcnt(8)" ::: "memory"); SBAR(); v_mma(o[0], fa, pa0, pa1, pa2, pa3); SBAR();
    v_issue<2>(fa, vb); asm volatile("s_waitcnt lgkmcnt(8)" ::: "memory"); SBAR(); v_mma(o[1], fb, pa0, pa1, pa2, pa3); SBAR();
    v_issue<3>(fb, vb); asm volatile("s_waitcnt lgkmcnt(8)" ::: "memory"); SBAR(); v_mma(o[2], fa, pa0, pa1, pa2, pa3); SBAR();
    asm volatile("s_waitcnt lgkmcnt(0)" ::: "memory"); SBAR(); v_mma(o[3], fb, pa0, pa1, pa2, pa3);
}
template <int DQ> struct Cst { static constexpr float SCALE = DQ == 128 ? 0.088388347648318440f : 0.072168783648703220f; static constexpr float C = SCALE * 1.4426950408889634f; };
constexpr float THR = 8.f;
template <int DQ> __device__ __forceinline__ void partialSM(f32x16& p0, f32x16& p1, float& m_reg, float& mn, float& alpha) {
    constexpr float C = Cst<DQ>::C, SC = Cst<DQ>::SCALE;
    float pmax = p0[0];
#pragma unroll
    for (int r = 1; r < 16; ++r) pmax = fmaxf(pmax, p0[r]);
#pragma unroll
    for (int r = 0; r < 16; ++r) pmax = fmaxf(pmax, p1[r]);
    { auto rr = __builtin_amdgcn_permlane32_swap(__float_as_uint(pmax), __float_as_uint(pmax), false, false); pmax = fmaxf(__uint_as_float(rr[0]), __uint_as_float(rr[1])); }
    if (__builtin_expect(__all(pmax - m_reg <= THR / SC), 1)) { mn = m_reg; alpha = 1.f; }
    else { mn = fmaxf(m_reg, pmax); alpha = __builtin_amdgcn_exp2f((m_reg - mn) * C); m_reg = mn; }
    const float mnC = -mn * C;
#pragma unroll
    for (int r = 0; r < 16; ++r) p0[r] = fmaf(p0[r], C, mnC);
#pragma unroll
    for (int r = 0; r < 16; ++r) p1[r] = fmaf(p1[r], C, mnC);
#pragma unroll
    for (int r = 0; r < 16; ++r) p0[r] = __builtin_amdgcn_exp2f(p0[r]);
}
__device__ __forceinline__ void finishSM(f32x16& p0, f32x16& p1, float alpha, float& l_reg, bf16x8& pa0, bf16x8& pa1, bf16x8& pa2, bf16x8& pa3) {
#pragma unroll
    for (int r = 0; r < 16; ++r) p1[r] = __builtin_amdgcn_exp2f(p1[r]);
    float ps = 0;
#pragma unroll
    for (int r = 0; r < 16; ++r) ps += p0[r];
#pragma unroll
    for (int r = 0; r < 16; ++r) ps += p1[r];
    { auto rr = __builtin_amdgcn_permlane32_swap(__float_as_uint(ps), __float_as_uint(ps), false, false); ps = __uint_as_float(rr[0]) + __uint_as_float(rr[1]); }
    l_reg = l_reg * alpha + ps;
#define PK4(P, BASE, OUT) do { unsigned a0 = pk2(P[BASE + 0], P[BASE + 1]), a1 = pk2(P[BASE + 2], P[BASE + 3]);   \
    unsigned b0 = pk2(P[BASE + 4], P[BASE + 5]), b1 = pk2(P[BASE + 6], P[BASE + 7]);                              \
    auto r0 = __builtin_amdgcn_permlane32_swap(a0, b0, false, false); auto r1 = __builtin_amdgcn_permlane32_swap(a1, b1, false, false); \
    v4u w_ = {r0[0], r1[0], r0[1], r1[1]}; OUT = *reinterpret_cast<bf16x8*>(&w_); } while (0)
    PK4(p0, 0, pa0); PK4(p0, 8, pa1); PK4(p1, 0, pa2); PK4(p1, 8, pa3);
#undef PK4
}
template <int DQ> __device__ __forceinline__ void qkt(f32x16& p0, f32x16& p1, const char* Ks, const bf16x8* qr, const bf16x8* qx, int r32, int hi, bool masked) {
    constexpr int NS = DQ / 16;
    p0 = f32x16{}; p1 = f32x16{};
    bf16x8 kb0[NS], kb1[NS], qf[NS];
#define QK_LOAD(d) do { const int cb_ = ((d) * 16 + hi * 8) * 2; kb0[d] = *reinterpret_cast<const bf16x8*>(Ks + kswz<DQ>(r32, cb_)); kb1[d] = *reinterpret_cast<const bf16x8*>(Ks + kswz<DQ>(32 + r32, cb_)); \
        qf[d] = ((d) < 8) ? qr[(d) < 8 ? (d) : 0] : qx[(d) < 8 ? 0 : (d) - 8]; } while (0)
    QK_LOAD(0); QK_LOAD(1); QK_LOAD(2); SBAR();
#pragma unroll
    for (int d0 = 0; d0 < NS; ++d0) {
        if (d0 + 3 < NS) { QK_LOAD(d0 + 3); }
        SBAR();
        p0 = __builtin_amdgcn_mfma_f32_32x32x16_bf16(kb0[d0], qf[d0], p0, 0, 0, 0);
        p1 = __builtin_amdgcn_mfma_f32_32x32x16_bf16(kb1[d0], qf[d0], p1, 0, 0, 0);
        SBAR();
    }
#undef QK_LOAD
    if (masked) {
#pragma unroll
        for (int r = 0; r < 16; ++r) { p0[r] = -1e30f; p1[r] = -1e30f; } }
}

template <int MODE, int DQ, int SDEPTH, int LDQ, int LDK, int LDV, int LDO, int DBG = 0, bool QROPE = false, bool STAG = false>
__device__ __forceinline__ void attn_unit(const bf16* Qb, const bf16* Kh, const bf16* Vh, bf16* Ob, const bf16* Gb, const float* qgain, int NT, int wlim, char* lds, const int tid_in, const bool live, const float* rlp = nullptr, const float* rtp = nullptr) {
    int tid = tid_in; asm volatile("" : "+v"(tid));
    constexpr int KCH = DQ / 8, KPT = 64 * KCH / NTHR;
    constexpr int SHM_V = KVBLK * DV * 2, SHM_K = KVBLK * DQ * 2;
    const int wid = __builtin_amdgcn_readfirstlane(tid >> 6), lane = tid & 63, r32 = lane & 31, hi = lane >> 5;
    char* V_lds = lds; char* K_lds = lds + 2 * SHM_V;
    float* ws = (float*)(lds + 2 * SHM_V + 2 * SHM_K) + wid * 64; float* li_l = ws; float* al_l = ws + 32;
    float m_reg = -1e30f, l_reg = 0; f32x16 o[4] = {}; bf16x8 qr[8], qx[4] = {};
    const bf16* Qw = Qb + (size_t)(wid * QBLK + r32) * LDQ + hi * 8;
    char* qlds = lds + 2 * SHM_V + 2 * SHM_K + 2048 + (wid * 256 + lane) * 16;
    __syncthreads();
#pragma unroll
    for (int d0 = 0; d0 < 8; ++d0) qr[d0] = *reinterpret_cast<const bf16x8*>(Qw + d0 * 16);
    if (DQ == 192 && !QROPE) {
#pragma unroll
        for (int d0 = 8; d0 < 12; ++d0) qx[d0 - 8] = *reinterpret_cast<const bf16x8*>(Qw + d0 * 16); }
    if (DQ == 192 && QROPE) {
        bf16x8 q8[4];
#pragma unroll
        for (int d0 = 8; d0 < 12; ++d0) q8[d0 - 8] = *reinterpret_cast<const bf16x8*>(Qw + d0 * 16);
        const int trow = wid * QBLK + r32;
        const float rlv = rlp[trow];
        const GAS f32x4* scp = (const GAS f32x4*)(rtp + (size_t)trow * 64 + hi * 16);
        f32x4 sc[2][4];
#pragma unroll
        for (int dd = 0; dd < 2; ++dd)
#pragma unroll
            for (int q_ = 0; q_ < 4; ++q_) sc[dd][q_] = scp[dd * 8 + q_];
        float s = 0.f;
#pragma unroll
        for (int d0 = 0; d0 < 8; ++d0)
#pragma unroll
            for (int e = 0; e < 8; ++e) { const float x = bf2f((bf16)qr[d0][e]); s += x * x; }
#pragma unroll
        for (int d0 = 0; d0 < 4; ++d0)
#pragma unroll
            for (int e = 0; e < 8; ++e) { const float x = bf2f((bf16)q8[d0][e]); s += x * x; }
        s = addx32(s);
        const float rsn = rlv / sqrtf(rlv * rlv * s * (1.f / 192) + EPS);
#pragma unroll
        for (int d0 = 0; d0 < 8; ++d0) { const GAS f32x4* gp = (const GAS f32x4*)(qgain + d0 * 16 + hi * 8); const f32x4 g0 = gp[0], g1 = gp[1]; v4u w_;
            w_[0] = pk2(bf2f((bf16)qr[d0][0]) * rsn * g0[0], bf2f((bf16)qr[d0][1]) * rsn * g0[1]); w_[1] = pk2(bf2f((bf16)qr[d0][2]) * rsn * g0[2], bf2f((bf16)qr[d0][3]) * rsn * g0[3]);
            w_[2] = pk2(bf2f((bf16)qr[d0][4]) * rsn * g1[0], bf2f((bf16)qr[d0][5]) * rsn * g1[1]); w_[3] = pk2(bf2f((bf16)qr[d0][6]) * rsn * g1[2], bf2f((bf16)qr[d0][7]) * rsn * g1[3]);
            qr[d0] = *reinterpret_cast<bf16x8*>(&w_); }
#pragma unroll
        for (int dd = 0; dd < 2; ++dd) {
            const GAS f32x4* g1p = (const GAS f32x4*)(qgain + 128 + dd * 16 + hi * 8); const GAS f32x4* g2p = (const GAS f32x4*)(qgain + 160 + dd * 16 + hi * 8);
            const f32x4 ga0 = g1p[0], ga1 = g1p[1], gb0 = g2p[0], gb1 = g2p[1]; float o1[8], o2[8];
#pragma unroll
            for (int e = 0; e < 8; ++e) { const float a = bf2f((bf16)q8[dd][e]) * rsn * (e < 4 ? ga0[e & 3] : ga1[e & 3]), b = bf2f((bf16)q8[2 + dd][e]) * rsn * (e < 4 ? gb0[e & 3] : gb1[e & 3]);
                const float sn = sc[dd][e >> 1][(e & 1) * 2], cs = sc[dd][e >> 1][(e & 1) * 2 + 1];
                o1[e] = a * cs - b * sn; o2[e] = a * sn + b * cs; }
            v4u w1_, w2_;
#pragma unroll
            for (int e = 0; e < 4; ++e) { w1_[e] = pk2(o1[2 * e], o1[2 * e + 1]); w2_[e] = pk2(o2[2 * e], o2[2 * e + 1]); }
            qx[dd] = *reinterpret_cast<bf16x8*>(&w1_); qx[2 + dd] = *reinterpret_cast<bf16x8*>(&w2_); }
    }
    if (MODE == 0) {
        float s = 0.f;
#pragma unroll
        for (int d0 = 0; d0 < 8; ++d0)
#pragma unroll
            for (int e = 0; e < 8; ++e) { const float x = bf2f((bf16)qr[d0][e]); s += x * x; }
        s = addx32(s);
        const float rs = 1.0f / sqrtf(s * (1.f / 128) + EPS);
#pragma unroll
        for (int d0 = 0; d0 < 8; ++d0) { const float* gp = qgain + d0 * 16 + hi * 8; v4u w_;
#pragma unroll
            for (int e = 0; e < 4; ++e) w_[e] = pk2(bf2f((bf16)qr[d0][2 * e]) * rs * gp[2 * e], bf2f((bf16)qr[d0][2 * e + 1]) * rs * gp[2 * e + 1]);
            qr[d0] = *reinterpret_cast<bf16x8*>(&w_); }
    }
    const int sr = tid >> 4, sc = (tid & 15) * 8, vst0 = v_st(sr, sc), vst1 = v_st(32 + sr, sc);
    int krow[KPT], kcol[KPT];
#pragma unroll
    for (int i = 0; i < KPT; ++i) { const int id = tid + NTHR * i; krow[i] = id / KCH; kcol[i] = (id % KCH) * 8; }
    const int vb0 = (int)(uintptr_t)V_lds + v_rd_base(lane);
    struct { bf16x8 vs0, vs1, ks[KPT]; } sr_[SDEPTH];
#define SLOAD(i, k0) do { sr_[i].vs0 = *reinterpret_cast<const bf16x8*>(&Vh[(size_t)((k0) + sr) * LDV + sc]); sr_[i].vs1 = *reinterpret_cast<const bf16x8*>(&Vh[(size_t)((k0) + 32 + sr) * LDV + sc]); \
    _Pragma("unroll") for (int q_ = 0; q_ < KPT; ++q_) sr_[i].ks[q_] = *reinterpret_cast<const bf16x8*>(&Kh[(size_t)((k0) + krow[q_]) * LDK + kcol[q_]]); } while (0)
#define SWRITE(b, i) do { *(bf16x8*)(V_lds + (b) * SHM_V + vst0) = sr_[i].vs0; *(bf16x8*)(V_lds + (b) * SHM_V + vst1) = sr_[i].vs1; \
    _Pragma("unroll") for (int q_ = 0; q_ < KPT; ++q_) *(bf16x8*)(K_lds + (b) * SHM_K + kswz<DQ>(krow[q_], kcol[q_] * 2)) = sr_[i].ks[q_]; } while (0)
#define SWAIT() do { if constexpr (SDEPTH == 2) asm volatile("s_waitcnt vmcnt(%0)" :: "n"(2 + KPT) : "memory"); else asm volatile("s_waitcnt vmcnt(0)" ::: "memory"); } while (0)
#define RESC(a) do { if (__any((a) < 1.f)) { if (hi == 0) al_l[r32] = (a); asm volatile("s_waitcnt lgkmcnt(0)" ::: "memory"); \
    _Pragma("unroll") for (int d = 0; d < 4; ++d) _Pragma("unroll") for (int r = 0; r < 16; ++r) o[d][r] *= al_l[crow(r, hi)]; } } while (0)
    f32x16 p0, p1; float mn = 0.f, al = 1.f; bf16x8 pa0, pa1, pa2, pa3;
    if constexpr (STAG) {
    const int grp = wid >> 2;
    SLOAD(0, 0); asm volatile("s_waitcnt vmcnt(0)" ::: "memory"); SWRITE(0, 0); __syncthreads();
    if (grp) { if (1 < NT) SLOAD(0, KVBLK); __syncthreads(); }
    for (int j = 0; j < NT; ++j) {
        const int bsel = j & 1;
        if (!grp) { if (j + 1 < NT) SLOAD(0, (j + 1) * KVBLK); }
        SBAR(); qkt<DQ>(p0, p1, K_lds + bsel * SHM_K, qr, qx, r32, hi, j > wlim); partialSM<DQ>(p0, p1, m_reg, mn, al);
        if (grp) { if (j + 1 < NT) { SWAIT(); SWRITE(bsel ^ 1, 0); } }
        __syncthreads();
        RESC(al); finishSM(p0, p1, al, l_reg, pa0, pa1, pa2, pa3); SBAR(); pv_d0(o, vb0 + bsel * SHM_V, pa0, pa1, pa2, pa3);
        if (!grp) { if (j + 1 < NT) { SWAIT(); SWRITE(bsel ^ 1, 0); } } else { if (j + 2 < NT) SLOAD(0, (j + 2) * KVBLK); }
        __syncthreads();
    }
    if (!grp) __syncthreads();
    } else {
    SLOAD(0, 0); asm volatile("s_waitcnt vmcnt(0)" ::: "memory"); SWRITE(0, 0); __syncthreads();
    for (int j = 0; j < NT; ++j) {
        const int bsel = j & 1;
        if (DBG != 1) { if (j + 1 < NT) SLOAD(0, (j + 1) * KVBLK); }
        SBAR();
        if (!(MODE == 1 && j > wlim)) {
        qkt<DQ>(p0, p1, K_lds + bsel * SHM_K, qr, qx, r32, hi, false);
        if (DBG != 2) { partialSM<DQ>(p0, p1, m_reg, mn, al);
        RESC(al);
        finishSM(p0, p1, al, l_reg, pa0, pa1, pa2, pa3); SBAR(); }
        else { asm volatile("" : "+v"(p0), "+v"(p1)); v4u w0_ = {__float_as_uint(p0[0]), __float_as_uint(p0[1]), __float_as_uint(p0[2]), __float_as_uint(p0[3])}, w1_ = {__float_as_uint(p1[0]), __float_as_uint(p1[1]), __float_as_uint(p1[2]), __float_as_uint(p1[3])};
               pa0 = *reinterpret_cast<bf16x8*>(&w0_); pa1 = *reinterpret_cast<bf16x8*>(&w1_); pa2 = pa0; pa3 = pa1; }
        pv_d0(o, vb0 + bsel * SHM_V, pa0, pa1, pa2, pa3);
        }
        if (DBG != 1) { if (j + 1 < NT) { SWAIT(); SWRITE(bsel ^ 1, 0); }
        __syncthreads(); }
    }
    }
    if (hi == 0) li_l[r32] = l_reg; asm volatile("s_waitcnt lgkmcnt(0)" ::: "memory");
    float rli[16];
#pragma unroll
    for (int r = 0; r < 16; ++r) rli[r] = __builtin_amdgcn_rcpf(li_l[crow(r, hi)]);
    char* stg = lds + wid * (32 * 256);
#pragma unroll
    for (int r = 0; r < 16; ++r) { const int orow = crow(r, hi);
#pragma unroll
        for (int d0 = 0; d0 < 4; ++d0) { const float ov = o[d0][r] * rli[r]; *(bf16*)(stg + orow * 256 + (d0 * 32 + r32) * 2) = (bf16)(pk2(ov, ov) & 0xffffu); } }
    asm volatile("s_waitcnt lgkmcnt(0)" ::: "memory");
    bf16* Ow = Ob + (size_t)(wid * QBLK) * LDO; const bf16* Gw = Gb + (size_t)(wid * QBLK) * LDO;
#pragma unroll
    for (int i = 0; i < 8; ++i) { const int row = i * 4 + (lane >> 4), ch = lane & 15; const size_t off = (size_t)row * LDO + ch * 8;
        const v4u sv_ = *(const v4u*)(stg + row * 256 + ch * 16); const v4u gv_ = *(const GAS v4u*)(Gw + off); v4u ov_;
#pragma unroll
        for (int e = 0; e < 4; ++e) ov_[e] = pk2(bflo(sv_[e]) * bflo(gv_[e]), bfhi(sv_[e]) * bfhi(gv_[e]));
        if (live) *(GAS v4u*)(Ow + off) = ov_; }
#undef SLOAD
#undef SWRITE
#undef SWAIT
#undef RESC
}
#undef SBAR
}

constexpr int NPH = 19;
#ifndef REP_KIND
#define REP_KIND (-1)
#endif
#ifndef REP_N
#define REP_N 1
#endif
#ifndef PROBE_SUB
#define PROBE_SUB 0
#endif
#ifndef EXTRA_BARS
#define EXTRA_BARS 0
#endif
__device__ __forceinline__ int opq(int v) { asm volatile("" : "+s"(v)); return v; }
#ifndef EN_MASK
#define EN_MASK 0xFFFFu
#endif
#define EN(k) (((EN_MASK) >> (k)) & 1u)
template <int MODE, int NU2> __device__ __forceinline__ void rs_table(LAS float* rsl, const pg8::StaticOrder& S, const float* src, int tid) {
#pragma unroll
    for (int k = 0; k < NU2; ++k) { const int idx = tid + NTHR * k, ui = __builtin_amdgcn_readfirstlane(idx >> 8), r = idx & 255; pg8::Unit u;
        if (S.next(ui, u)) { const size_t row = (size_t)u.pm * 256 + r; float v;
            if (MODE == 0) v = src[row];
            else { const GAS f32x4* p = (const GAS f32x4*)(src + row * 16); const f32x4 a = p[0], b = p[1], c = p[2], d = p[3];
                   const float s_ = (((a.x + a.y) + (a.z + a.w)) + ((b.x + b.y) + (b.z + b.w))) + (((c.x + c.y) + (c.z + c.w)) + ((d.x + d.y) + (d.z + d.w)));
                   v = 1.0f / sqrtf(s_ * (1.f / DM) + EPS); }
            rsl[idx] = v; } }
    __syncthreads();
}
__device__ __forceinline__ void ckv_rs_table(LAS float* rsl, const pg8::StaticOrder& S, const bf16* CKV, int tid) {
    const int wv = __builtin_amdgcn_readfirstlane(tid >> 6), lane = tid & 63; pg8::Unit u;
    for (int ui = 0; S.next(ui, u); ++ui) {
#pragma unroll
        for (int st = 0; st < 8; ++st) { const int r = wv * 32 + st * 4 + (lane >> 4); const GAS v4u* p = (const GAS v4u*)(CKV + ((size_t)u.pm * 256 + r) * 256) + (lane & 15) * 2;
            const v4u a = p[0], b = p[1]; float s_ = 0.f;
#pragma unroll
            for (int e = 0; e < 4; ++e) { s_ += bflo(a[e]) * bflo(a[e]) + bfhi(a[e]) * bfhi(a[e]); s_ += bflo(b[e]) * bflo(b[e]) + bfhi(b[e]) * bfhi(b[e]); }
            s_ = sum16(s_);
            if ((lane & 15) == 0) rsl[ui * 256 + r] = 1.0f / sqrtf(s_ * (1.f / 256) + EPS); } }
    __syncthreads();
}
__device__ __forceinline__ void hs_table(LAS float* tab, const pg8::StaticOrder& S, const float* SSH, int tid) {
    const int ui = __builtin_amdgcn_readfirstlane(tid >> 8), r = tid & 255; pg8::Unit u;
    if (S.next(ui, u)) { const GAS f32x4* p = (const GAS f32x4*)(SSH + ((size_t)u.pm * 256 + r) * 16); float rs_[4];
#pragma unroll
        for (int h_ = 0; h_ < 4; ++h_) { const f32x4 a = p[h_]; rs_[h_] = 1.0f / sqrtf(((a.x + a.y) + (a.z + a.w)) * (1.f / 256) + EPS); }
        *(LAS f32x4*)(tab + (size_t)tid * 4) = (f32x4){rs_[0] / rs_[1], rs_[1] / rs_[2], rs_[2] / rs_[3], rs_[3]}; }
    __syncthreads();
}
__global__ void __launch_bounds__(NTHR, 2) yoco_fwd(Args args) {
    extern __shared__ __attribute__((aligned(16))) unsigned char lds[];
    LAS unsigned char* L = (LAS unsigned char*)lds;
    volatile LAS unsigned* MISC = (volatile LAS unsigned*)(L + MISC_OFF);
    const int tid0 = threadIdx.x, wave0 = __builtin_amdgcn_readfirstlane(tid0 >> 6);
    if (tid0 < 64) MISC[tid0] = 0u;
    __syncthreads();
    if ((args.ph_hi - args.ph_lo) > 1) (void)xcd_barrier_post((unsigned*)(args.ws + WS_CTL) + CW_BAR, MISC + 8);

    const int ph_lo = args.ph_lo, ph_hi = args.ph_hi;
    int rep_left = REP_N - 1;
    for (int ph = ph_lo; ph < ph_hi; ++ph) {
        const __attribute__((address_space(4))) Args* ap_ = (const __attribute__((address_space(4))) Args*)__builtin_amdgcn_kernarg_segment_ptr();
        asm volatile("" : "+s"(ap_));
#define ARG_IN(i) (ap_->in[i])
        unsigned char* ws = ap_->ws;
        const float* x_in = ARG_IN(I_X); float* xo = ap_->out;
        bf16* H = (bf16*)(ws + WS_H); float* IFb = (float*)(ws + WS_IF); float* RSb = (float*)(ws + WS_RS); float* SSQb = (float*)(ws + WS_SSQ);
        bf16* QUb = (bf16*)xo;
        bf16* MKb = (bf16*)(ws + WS_MK); bf16* MVb = (bf16*)(ws + WS_MV);
        int wave = wave0, G = (int)gridDim.x, bx = (int)blockIdx.x;
        asm volatile("" : "+s"(wave), "+s"(G), "+s"(bx));
        const int vcu = (G % 8 == 0) ? (bx % 8) * (G / 8) + bx / 8 : bx;
        const int gw = vcu * NWAVES + wave, NGW = G * NWAVES;
#define PH_TID() unsigned z_; asm volatile("v_mov_b32 %0, 0" : "=v"(z_)); const int tid = wave * 64 + (int)__builtin_amdgcn_mbcnt_hi(~0u, __builtin_amdgcn_mbcnt_lo(~0u, z_)); const int lane = tid & 63; (void)lane
        int kind, l = 0;
        if (ph < 2) kind = ph;
        else if (ph < 6) { const int k = ph - 2; kind = (k < 3) ? 10 + k : 14; }
        else if (ph < 10) { l = 1; const int k = ph - 6; kind = (k < 3) ? 10 + k : 14; }
        else if (ph < 15) { const int k = ph - 10; kind = (k < 2) ? 20 + k : 21 + k; }
        else { l = 1; const int k = ph - 15; kind = (k < 2) ? 20 + k : 22 + k; }
        const int kindrep = (kind == 21) ? 11 : (kind == 25) ? 14 : (kind == 26) ? 15 : kind;
        const bool live = !(REP_N > 1 && kindrep == REP_KIND && rep_left > 0);

        if (EN(0) && kind == 0) {
            PH_TID();
            LAS float* scr = (LAS float*)(L + wave * 16384);
            int base = 0;
            for (int j = 0; j < N_TJOBS; ++j) { const TJob J = tjob(j, ap_); const int items = (J.K / 64) * (J.nd / 32);
                int first = (gw - base) % NGW; if (first < 0) first += NGW;
                for (int it = first; it < items; it += NGW) p0_transpose_item(J, scr, it, lane);
                base += items; }
            { float* wif = (float*)(ws + WS_WIF);
              for (int i = bx * NTHR + tid; i < 2 * 8 * DM; i += G * NTHR) { const int ll = i >> 13, g8 = (i >> 10) & 7, k = i & 1023;
                  wif[i] = ARG_IN(I_AWIN)[(size_t)ll * DM * A_IN + (size_t)k * A_IN + 5120 + g8] * ARG_IN(I_ANORM)[ll * DM + k]; } }
            { float* rt = (float*)(ws + WS_ROPE); const int* pos = (const int*)ARG_IN(I_POS);
              for (int i = bx * NTHR + tid; i < T * 32; i += G * NTHR) { float sn, cs; rope_sincos(pos[i >> 5], i & 31, sn, cs); rt[2 * i] = sn; rt[2 * i + 1] = cs; } }
            { bf16* MEMN = (bf16*)(ws + WS_MEMN);
              for (int m = gw; m < TM; m += NGW) row_norm_to_bf16<false>(ARG_IN(I_MEM) + (size_t)m * DM, MEMN + (size_t)m * DM, (const LAS f32x4*)nullptr, nullptr, nullptr, nullptr, nullptr, lane); }
        } else if (EN(1) && kind == 1) {
            PH_TID();
            wif_to_lds((LAS f32x4*)L, (const float*)(ws + WS_WIF), tid);
            for (int m = gw; m < T; m += NGW) row_norm_to_bf16<true>(x_in + (size_t)m * DM, H + (size_t)m * DM, (const LAS f32x4*)L, ARG_IN(I_AIGB), ARG_IN(I_AFGB), IFb + (size_t)m * 8, RSb + m, lane);
            __syncthreads();
            pg8::Gemm g{(const bf16*)(ws + WS_MEMN), (const bf16*)(ws + WS_MEMN), (const bf16*)(ws + WS_WMEM), TM, 4096, opq(DM), opq(DM), opq(DM / 64)};
            pg8::StaticOrder S; S.init(TM, 4096, G, bx); pg8::EpiMemKV E{MKb, MVb};
            pg8::gemm_phase<pg8::EpiMemKV, pg8::StaticOrder, true, true>(L, g, S, E, tid);
        } else if (EN(2) && kind == 10) {
            PH_TID();
            if (l == 0) { for (int idx = gw; idx < 4 * TM; idx += 4 * NGW) head128_norm4<4>(MKb, ARG_IN(I_MEMKG), idx, NGW, lane); }
            pg8::Gemm g{H, H, (const bf16*)(ws + WS_WINA + l * WINA_STRIDE), T, NA, opq(DM), opq(DM), opq(DM / 64)};
            pg8::StaticOrder S; S.init(T, NA, G, bx);
            if (l == 0) rs_table<0, 6>((LAS float*)(L + RING_BYTES), S, RSb, tid);
            else { wif_to_lds((LAS f32x4*)L, (const float*)(ws + WS_WIF) + 8 * DM, tid);
                   for (int m = gw; m < T; m += 4 * NGW) rows_gates_bf16<4>(H, (const LAS f32x4*)L, ARG_IN(I_AIGB) + 4, ARG_IN(I_AFGB) + 4, IFb, RSb, m, NGW, lane);
                   rs_table<1, 6>((LAS float*)(L + RING_BYTES), S, SSQb, tid); }
            pg8::EpiA E{(bf16*)(ws + WS_QKR), (bf16*)(ws + WS_HALO), (bf16*)(ws + WS_V), (bf16*)(ws + WS_G), (bf16*)(ws + WS_MQA), (const LAS float*)(L + RING_BYTES), (bf16*)(ws + WS_HALO2), ARG_IN(I_ACONVW) + l * 4 * 2048, ARG_IN(I_ACONVB) + l * 2048, L + CWIN_OFF};
#if PROBE_SUB == 7 || PROBE_SUB == 8 || PROBE_SUB == 9
            if (!live) { pg8::EpiStore E0{(bf16*)(ws + WS_QKR), PROBE_SUB == 9 ? opq(0) : 2048, opq(PROBE_SUB == 7 ? 0 : 1)}; pg8::gemm_phase<pg8::EpiStore, pg8::StaticOrder, true, true>(L, g, S, E0, tid); } else
#endif
            pg8::gemm_phase<pg8::EpiA, pg8::StaticOrder, true, true>(L, g, S, E, tid);
        } else if (EN(3) && (kind == 11 || kind == 21)) {
            PH_TID();
            const int layer = (kind == 11) ? l : 2 + l;
            bf16* MQ = (bf16*)(ws + (kind == 11 ? WS_MQA : WS_MQB));
            if (kind == 11) for (int it = gw; it < BATCH * 4 * 32; it += NGW) ml::gate_scan_item(IFb, (float*)(ws + WS_GATE), it, lane);
            if (kind == 11) { for (int gid = bx * NTHR + tid; gid < (T / 64) * 256; gid += G * NTHR) conv_fixup((bf16*)(ws + WS_QKR), (const bf16*)(ws + WS_HALO), (const bf16*)(ws + WS_HALO2), ARG_IN(I_ACONVW) + l * 4 * 2048, ARG_IN(I_ACONVB) + l * 2048, gid, true); }
            else { for (int m = gw; m < T; m += 8 * NGW) rows_rs384<8>((const bf16*)(ws + WS_QLAT), (float*)(ws + WS_RL), m, NGW, lane); }
            if (live || PROBE_SUB == 0) for (int u = vcu; u < BATCH * 4 * 8; u += G) { const int qb = u & 7, hh = (u >> 3) & 3, b = u >> 5;
                bf16* Qb = MQ + ((size_t)b * SEQ + qb * 256) * 1024 + hh * 128;
                const bf16* Kh = MKb + (size_t)layer * TM * 512 + (size_t)b * NMEM * 512 + hh * 128; const bf16* Vh = MVb + (size_t)layer * TM * 512 + (size_t)b * NMEM * 512 + hh * 128;
                at::attn_unit<0, 128, 1, 1024, 512, 512, 1024>(Qb, Kh, Vh, Qb, Qb + 512, ARG_IN(I_MEMQG) + layer * 128, 4, 3, (char*)lds, tid, live); }
            if (kind == 21) {
                __syncthreads();
                { pg8::Gemm g{(const bf16*)(ws + WS_QLAT), (const bf16*)(ws + WS_QLAT), (const bf16*)(ws + WS_WQUP + l * WQUP_STRIDE), T, 1536, opq(384), opq(384), opq(384 / 64)};
                  pg8::StaticOrder S; S.init(T, 1536, G, bx); pg8::EpiStore E{QUb, 1536, 1};
                  pg8::gemm_phase<pg8::EpiStore, pg8::StaticOrder, true, true>(L, g, S, E, tid); }
                if (l == 0) {
                  pg8::Gemm g{(const bf16*)(ws + WS_CKV), (const bf16*)(ws + WS_CKV), (const bf16*)(ws + WS_WKVB), T, 2048, opq(256), opq(256), opq(256 / 64)};
                  pg8::StaticOrder S; S.init(T, 2048, G, bx);
                  ckv_rs_table((LAS float*)(L + RING_BYTES), S, (const bf16*)(ws + WS_CKV), tid);
                  pg8::EpiKvb E{(bf16*)(ws + WS_KSH), (bf16*)(ws + WS_VSH), (const LAS float*)(L + RING_BYTES)};
                  pg8::gemm_phase<pg8::EpiKvb, pg8::StaticOrder, true, true>(L, g, S, E, tid); }
            }
        } else if (EN(4) && kind == 12) {
            PH_TID();
            for (int it = vcu; it < BATCH * 4 * 4; it += G) ml::mlstm_item(L, (const bf16*)(ws + WS_QKR), (bf16*)(ws + WS_V), (const bf16*)(ws + WS_G), (float*)(ws + WS_SSH), (const float*)(ws + WS_GATE), it >> 4, (it >> 2) & 3, it & 3, tid, live);
        } else if (EN(6) && (kind == 14 || kind == 25)) {
            PH_TID();
            const bool isA = (kind == 14);
            const bf16* A1 = (const bf16*)(ws + (isA ? WS_V : WS_ZB)); const bf16* A2 = (const bf16*)(ws + (isA ? WS_MQA : WS_MQB));
            const bf16* Wt = (const bf16*)(ws + (isA ? WS_WOUTA : WS_WOUTB) + l * WOUT_STRIDE);
            pg8::Gemm g{A1, A2, Wt, T, DM, opq(1536), opq(DM), opq(DM / 64)};
            pg8::StaticOrder S; S.init(T, DM, G, bx);
            if (!isA && l == 1) { pg8::EpiResF E{H, xo, live ? 1 : 0}; pg8::gemm_phase<pg8::EpiResF, pg8::StaticOrder, true, true>(L, g, S, E, tid); }
            else if (isA) { hs_table((LAS float*)(L + RING_BYTES), S, (const float*)(ws + WS_SSH), tid);
                            pg8::EpiResBA E{{H, SSQb, live ? 1 : 0}, (const LAS float*)(L + RING_BYTES)}; pg8::gemm_phase<pg8::EpiResBA, pg8::StaticOrder, true, true>(L, g, S, E, tid); }
            else { pg8::EpiResB E{H, SSQb, live ? 1 : 0}; pg8::gemm_phase<pg8::EpiResB, pg8::StaticOrder, true, true>(L, g, S, E, tid); }
        } else if (EN(8) && kind == 20) {
            PH_TID();
            pg8::Gemm g{H, H, (const bf16*)(ws + (l == 0 ? WS_WINB0 : WS_WINB1)), T, l == 0 ? NB0 : NB1, opq(DM), opq(DM), opq(DM / 64)};
            pg8::StaticOrder S; S.init(T, l == 0 ? NB0 : NB1, G, bx);
            rs_table<1, 3>((LAS float*)(L + RING_BYTES), S, SSQb, tid);
            pg8::EpiB E{(bf16*)(ws + WS_ZB), (bf16*)(ws + WS_MQB), (bf16*)(ws + WS_QLAT), l == 0 ? (bf16*)(ws + WS_CKV) : nullptr, (bf16*)(ws + WS_KPE), (const LAS float*)(L + RING_BYTES)};
            pg8::gemm_phase<pg8::EpiB, pg8::StaticOrder, true, true>(L, g, S, E, tid);
        } else if (EN(10) && kind == 23) {
            PH_TID();
            const float* rt = (const float*)(ws + WS_ROPE);
            for (int t = gw; t < T; t += 2 * NGW) rope_tokens<2>((bf16*)(ws + WS_KSH), (const bf16*)(ws + WS_KPE), nullptr, ARG_IN(I_KGAIN), rt, t, NGW, lane, live);
        } else if (EN(11) && kind == 24) {
            PH_TID();
            for (int v = vcu; v < 256; v += G) { const int bh = v >> 1, half = v & 1, b = bh >> 3, hh = bh & 7;
                for (int i = 3; i >= 0; --i) { const int qb = half ? (i == 0 ? 1 : i == 1 ? 2 : i == 2 ? 5 : 6) : (i == 0 ? 0 : i == 1 ? 3 : i == 2 ? 4 : 7);
                    const bf16* Qb = (const bf16*)QUb + ((size_t)b * SEQ + qb * 256) * 1536 + hh * 192;
                    const bf16* Kh = (const bf16*)(ws + WS_KSH) + (size_t)b * SEQ * 1536 + hh * 192; const bf16* Vh = (const bf16*)(ws + WS_VSH) + (size_t)b * SEQ * 1024 + hh * 128;
                    bf16* Ob = (bf16*)(ws + WS_ZB) + ((size_t)b * SEQ + qb * 256) * 1024 + hh * 128;
                    const float* rlq = (const float*)(ws + WS_RL) + ((size_t)b * SEQ + qb * 256); const float* rtq = (const float*)(ws + WS_ROPE) + ((size_t)b * SEQ + qb * 256) * 64;
#if PROBE_SUB == 21 || PROBE_SUB == 22
                    if (!live) at::attn_unit<1, 192, 1, 1536, 1536, 1024, 1024, PROBE_SUB - 20, true>(Qb, Kh, Vh, Ob, Ob, ARG_IN(I_BQGAIN) + l * 192, 4 * qb + 4, 4 * qb + (wave >> 1), (char*)lds, tid, live, rlq, rtq); else
#endif
                    at::attn_unit<1, 192, 1, 1536, 1536, 1024, 1024, 0, true>(Qb, Kh, Vh, Ob, Ob, ARG_IN(I_BQGAIN) + l * 192, 4 * qb + 4, 4 * qb + (wave >> 1), (char*)lds, tid, live, rlq, rtq); } }
        }
        if (REP_N > 1) { if (!live) { --rep_left; --ph; } else rep_left = REP_N - 1; }
        if (ph + 1 < ph_hi) { XcdBarrier bb; bb.bar = (unsigned*)(ws + WS_CTL) + CW_BAR; bb.x = xb_xcc_id(); bb.st = (volatile LAS unsigned*)(L + MISC_OFF) + 8; xcd_barrier(bb); if (EXTRA_BARS > 0 && ph == 0) for (int e_ = 0; e_ < EXTRA_BARS; ++e_) xcd_barrier(bb); }
#undef ARG_IN
#undef PH_TID
    }
}

extern "C" void kernel_launch(void* const* d_in, const int* in_sizes, int n_in, void* d_out, int out_size, void* d_ws, size_t ws_size, hipStream_t stream) {
    static int grid = 0;
    if (grid == 0) {
        if (n_in != 26 || in_sizes[0] != T * DM || out_size != T * DM || ws_size < WS_END) {
            fprintf(stderr, "kernel_launch: built for 26 inputs, x/out of %d floats, >= %zu bytes of workspace; got n_in %d, in0 %d, out %d, ws %zu; nothing launched\n", T * DM, (size_t)WS_END, n_in, n_in > 0 ? in_sizes[0] : -1, out_size, ws_size);
            grid = -1; return; }
        int dev = 0, cus = 0;
        if (hipGetDevice(&dev) != hipSuccess || hipDeviceGetAttribute(&cus, hipDeviceAttributeMultiprocessorCount, dev) != hipSuccess) { fprintf(stderr, "kernel_launch: device query failed\n"); grid = -1; return; }
        if (hipFuncSetAttribute((const void*)yoco_fwd, hipFuncAttributeMaxDynamicSharedMemorySize, LDS_BYTES) != hipSuccess) { fprintf(stderr, "kernel_launch: hipFuncSetAttribute failed\n"); grid = -1; return; }
        int per_cu = 0;
        if (hipOccupancyMaxActiveBlocksPerMultiprocessor(&per_cu, (const void*)yoco_fwd, NTHR, LDS_BYTES) != hipSuccess || per_cu < 1) fprintf(stderr, "kernel_launch: note: occupancy query reports %d per CU\n", per_cu);
        (void)hipGetLastError();
        if (cus != 256) { fprintf(stderr, "kernel_launch: built for a 256-CU device (one workgroup per CU, work dealt in multiples of 256); this device reports %d; nothing launched\n", cus); grid = -1; return; }
        grid = cus;
    }
    if (grid < 0) return;
    if (hipMemsetAsync((char*)d_ws + WS_CTL, 0, CTL_ZERO_BYTES, stream) != hipSuccess) { fprintf(stderr, "kernel_launch: memset failed\n"); return; }
    Args a{};
    for (int i = 0; i < 26; ++i) a.in[i] = (const float*)d_in[i];
    a.out = (float*)d_out; a.ws = (unsigned char*)d_ws;
    if (MK_N_LAUNCHES == 1) { a.ph_lo = 0; a.ph_hi = NPH; hipLaunchKernelGGL(yoco_fwd, dim3(grid), dim3(NTHR), LDS_BYTES, stream, a); }
    else { for (int p = 0; p < NPH; ++p) { a.ph_lo = p; a.ph_hi = p + 1; hipLaunchKernelGGL(yoco_fwd, dim3(grid), dim3(NTHR), LDS_BYTES, stream, a); } }
    const hipError_t le = hipPeekAtLastError();
    if (le != hipSuccess) fprintf(stderr, "kernel_launch: launch failed: %s\n", hipGetErrorName(le));
}
```
